# Optimizing an MI355X kernel written in HIP

```python
import jax, jax.numpy as jnp
from jax import lax
import numpy as np

D_MODEL = 1024
BATCH = 4
SEQ = 8192
DEPTH = 4

N_META = 16
BLOCK = 128
PAD = BLOCK - N_META
MLA_HEADS = 8
MLA_NOPE = 64
MLA_ROPE = 32
MLA_QK = MLA_NOPE + MLA_ROPE
MLA_V = 64
Q_LORA = 384
KV_LORA = 256
ROPE_BASE = 10000.0
FOX_HEADS = 8
FOX_DIM = 64
CONV_WIDTH = 3
D_FF = 4 * D_MODEL
EPS = 1e-6
NEG = -1e30
N_EVEN = (DEPTH + 1) // 2
N_ODD = DEPTH // 2
ATTN_SPLITS = (Q_LORA, KV_LORA, MLA_ROPE, FOX_HEADS * FOX_DIM, FOX_HEADS * FOX_DIM, FOX_HEADS * FOX_DIM, FOX_HEADS)
ATTN_IN = Q_LORA + KV_LORA + MLA_ROPE + 3 * FOX_HEADS * FOX_DIM + FOX_HEADS
MIX_OUT = MLA_HEADS * MLA_V + FOX_HEADS * FOX_DIM

kernel_name = "hybrid_mla_fox_shortconv_trunk"


def _offsets(sizes):
    out, acc = [], 0
    for s in sizes[:-1]:
        acc += s
        out.append(acc)
    return out


def rms_norm(x, g):
    xf = x.astype(jnp.float32)
    y = xf * lax.rsqrt(jnp.mean(xf * xf, axis=-1, keepdims=True) + EPS)
    return (y * g.astype(jnp.float32)).astype(x.dtype)


def rope_tables(length):
    pos = jnp.arange(length, dtype=jnp.float32)
    inv_freq = ROPE_BASE ** (-jnp.arange(0, MLA_ROPE, 2, dtype=jnp.float32) / MLA_ROPE)
    ang = pos[:, None] * inv_freq[None, :]
    return jnp.cos(ang), jnp.sin(ang)


def rope_tail(x, cos, sin):
    x_nope = x[..., :MLA_NOPE]
    xr = x[..., MLA_NOPE:].astype(jnp.float32)
    x1, x2 = xr[..., : MLA_ROPE // 2], xr[..., MLA_ROPE // 2:]
    c, s = cos[None, :, None, :], sin[None, :, None, :]
    rot = jnp.concatenate([x1 * c - x2 * s, x2 * c + x1 * s], axis=-1).astype(x.dtype)
    return jnp.concatenate([x_nope, rot], axis=-1)


def pad_front(x):
    return jnp.pad(x, [(0, 0), (PAD, 0)] + [(0, 0)] * (x.ndim - 2))


def blocked_causal_attention(q, k, v, scale, cum_log_f=None):
    b, lp, h, dk = q.shape
    nb = lp // BLOCK
    key_pos = jnp.arange(lp)
    qb = q.reshape(b, nb, BLOCK, h, dk).transpose(1, 0, 2, 3, 4)
    use_decay = cum_log_f is not None
    if use_decay:
        f_bh = cum_log_f.transpose(0, 2, 1)
        f_q = f_bh.reshape(b, h, nb, BLOCK).transpose(2, 0, 1, 3)
        xs = (jnp.arange(nb), qb, f_q)
    else:
        xs = (jnp.arange(nb), qb)

    def one_block(args):
        if use_decay:
            i, q_blk, fq = args
        else:
            i, q_blk = args
        s = jnp.einsum('bqhd,bkhd->bhqk', q_blk, k, preferred_element_type=jnp.float32) * scale
        if use_decay:
            s = s + fq[..., :, None] - f_bh[:, :, None, :]
        q_pos = i * BLOCK + jnp.arange(BLOCK)
        mask = (key_pos[None, :] <= q_pos[:, None]) & (key_pos[None, :] >= PAD)
        s = jnp.where(mask[None, None], s, NEG)
        p = jax.nn.softmax(s, axis=-1)
        return jnp.einsum('bhqk,bkhd->bqhd', p.astype(v.dtype), v)

    out = lax.map(one_block, xs)
    return out.transpose(1, 0, 2, 3, 4).reshape(b, lp, h, v.shape[-1])


def attention_mixer(h, cos, sin, w_in, g_cq, w_uq, g_ckv, w_ukv, g_q_mla, g_k_mla,
                    g_q_fox, g_k_fox, b_forget, w_out):
    b, l, _ = h.shape
    z = h @ w_in
    c_q, c_kv, k_pe, fq, fk, fv, f_logit = jnp.split(z, _offsets(ATTN_SPLITS), axis=-1)

    q = (rms_norm(c_q, g_cq) @ w_uq).reshape(b, l, MLA_HEADS, MLA_QK)
    kv = (rms_norm(c_kv, g_ckv) @ w_ukv).reshape(b, l, MLA_HEADS, MLA_NOPE + MLA_V)
    k_nope, v_mla = kv[..., :MLA_NOPE], kv[..., MLA_NOPE:]
    k_rope = jnp.broadcast_to(k_pe[:, :, None, :], (b, l, MLA_HEADS, MLA_ROPE))
    k = jnp.concatenate([k_nope, k_rope], axis=-1)
    q = rope_tail(rms_norm(q, g_q_mla), cos, sin)
    k = rope_tail(rms_norm(k, g_k_mla), cos, sin)
    o_mla = blocked_causal_attention(pad_front(q), pad_front(k), pad_front(v_mla),
                                     MLA_QK ** -0.5)[:, PAD:]
    o_mla = o_mla.reshape(b, l, MLA_HEADS * MLA_V)

    qf = rms_norm(fq.reshape(b, l, FOX_HEADS, FOX_DIM), g_q_fox)
    kf = rms_norm(fk.reshape(b, l, FOX_HEADS, FOX_DIM), g_k_fox)
    vf = fv.reshape(b, l, FOX_HEADS, FOX_DIM)
    log_f = jax.nn.log_sigmoid(f_logit.astype(jnp.float32) + b_forget.astype(jnp.float32))
    cum_log_f = jnp.cumsum(pad_front(log_f), axis=1)
    o_fox = blocked_causal_attention(pad_front(qf), pad_front(kf), pad_front(vf),
                                     FOX_DIM ** -0.5, cum_log_f)[:, PAD:]
    o_fox = o_fox.reshape(b, l, FOX_HEADS * FOX_DIM)

    return jnp.concatenate([o_mla, o_fox], axis=-1) @ w_out


def short_conv_mixer(h, w_in, conv_w, w_out):
    z = h @ w_in
    gate_b, gate_c, u = jnp.split(z, 3, axis=-1)
    g = gate_c * u
    y = lax.conv_general_dilated(
        g, conv_w[:, None, :].astype(g.dtype), window_strides=(1,),
        padding=[(CONV_WIDTH - 1, 0)], dimension_numbers=('NWC', 'WIO', 'NWC'),
        feature_group_count=D_MODEL)
    return (gate_b * y) @ w_out


def sq_relu_mlp(h, w_up, w_down):
    return jnp.square(jax.nn.relu(h @ w_up)) @ w_down


def setup_inputs(seed: int = 0) -> dict:
    key = jax.random.key(seed)
    ks = iter(jax.random.split(key, 32))

    def nrm(shape, scale):
        return jax.random.normal(next(ks), shape, jnp.float32) * scale

    def gain(shape):
        return 1.0 + 0.02 * jax.random.normal(next(ks), shape, jnp.float32)

    out_scale = (2.0 * DEPTH) ** -0.5
    return {
        "x": nrm((BATCH, SEQ, D_MODEL), 1.0),
        "meta_tokens": nrm((N_META, D_MODEL), 1.0),
        "g_mix": gain((DEPTH, D_MODEL)),
        "g_mlp": gain((DEPTH, D_MODEL)),
        "w_in_attn": nrm((N_EVEN, D_MODEL, ATTN_IN), D_MODEL ** -0.5),
        "g_cq": gain((N_EVEN, Q_LORA)),
        "w_uq": nrm((N_EVEN, Q_LORA, MLA_HEADS * MLA_QK), Q_LORA ** -0.5),
        "g_ckv": gain((N_EVEN, KV_LORA)),
        "w_ukv": nrm((N_EVEN, KV_LORA, MLA_HEADS * (MLA_NOPE + MLA_V)), KV_LORA ** -0.5),
        "g_q_mla": gain((N_EVEN, MLA_QK)),
        "g_k_mla": gain((N_EVEN, MLA_QK)),
        "g_q_fox": gain((N_EVEN, FOX_DIM)),
        "g_k_fox": gain((N_EVEN, FOX_DIM)),
        "b_forget": 2.0 + nrm((N_EVEN, FOX_HEADS), 0.1),
        "w_out_attn": nrm((N_EVEN, MIX_OUT, D_MODEL), MIX_OUT ** -0.5 * out_scale),
        "w_in_conv": nrm((N_ODD, D_MODEL, 3 * D_MODEL), D_MODEL ** -0.5),
        "conv_w": nrm((N_ODD, CONV_WIDTH, D_MODEL), CONV_WIDTH ** -0.5),
        "w_out_conv": nrm((N_ODD, D_MODEL, D_MODEL), D_MODEL ** -0.5 * out_scale),
        "w_mlp_up": nrm((DEPTH, D_MODEL, D_FF), D_MODEL ** -0.5),
        "w_mlp_down": nrm((DEPTH, D_FF, D_MODEL), D_FF ** -0.5 * out_scale),
    }


def reference(x, meta_tokens, g_mix, g_mlp, w_in_attn, g_cq, w_uq, g_ckv, w_ukv,
              g_q_mla, g_k_mla, g_q_fox, g_k_fox, b_forget, w_out_attn,
              w_in_conv, conv_w, w_out_conv, w_mlp_up, w_mlp_down):
    b = x.shape[0]
    meta = jnp.broadcast_to(meta_tokens.astype(x.dtype)[None], (b, N_META, D_MODEL))
    h = jnp.concatenate([meta, x], axis=1)
    cos, sin = rope_tables(h.shape[1])
    for layer in range(DEPTH):
        j = layer // 2
        hn = rms_norm(h, g_mix[layer])
        if layer % 2 == 0:
            h = h + attention_mixer(hn, cos, sin, w_in_attn[j], g_cq[j], w_uq[j], g_ckv[j],
                                    w_ukv[j], g_q_mla[j], g_k_mla[j], g_q_fox[j], g_k_fox[j],
                                    b_forget[j], w_out_attn[j])
        else:
            h = h + short_conv_mixer(hn, w_in_conv[j], conv_w[j], w_out_conv[j])
        h = h + sq_relu_mlp(rms_norm(h, g_mlp[layer]), w_mlp_up[layer], w_mlp_down[layer])
    return h[:, N_META:]
```

```cpp
#include <hip/hip_runtime.h>
#include <hip/hip_cooperative_groups.h>
#include <cstdio>
#include <cstdint>
namespace cg = cooperative_groups;
__device__ __forceinline__ int opaque_tid() { int t = threadIdx.x; asm volatile("" : "+v"(t)); return t; }

namespace pg8 {
#define PG8_LAS __attribute__((address_space(3)))
typedef unsigned short bf16_t;
typedef short bf16x8 __attribute__((ext_vector_type(8)));
typedef float f32x4 __attribute__((ext_vector_type(4)));
typedef unsigned u32x4 __attribute__((ext_vector_type(4)));
constexpr int BM = 256, BK = 64, HALF = 128, HTB = HALF * BK * 2  , STAGE_BYTES = 8 * HTB, NXCD = 8, WGM = 8;

__host__ __device__ __forceinline__ int lds_byte(int r, int c) { const int st = (r >> 4) * 2 + (c >> 5), rr = r & 15, cc = c & 31, ob = rr * 64 + cc * 2; return st * 1024 + (ob ^ (((ob >> 9) & 1) << 5)); }
__host__ __device__ __forceinline__ void stage_rc(int b, int& R, int& C) { const int st = b / 1024, sb = b % 1024, swz = sb ^ (((sb >> 9) & 1) << 5); R = (st >> 1) * 16 + swz / 64; C = (st & 1) * 32 + (swz % 64) / 2; }
__host__ __device__ __forceinline__ int perm32(int rho) { const int n = rho >> 4, i = rho & 15; return 8 * (i >> 2) + 4 * n + (i & 3); }

struct Unit { int pm, pn, ko; };
struct Gemm { const bf16_t* A; const bf16_t* Bt; int M, N, K, nt; };

struct StaticOrder {
    int nM, nN, nwg, G, c;
    __host__ __device__ void init(int M, int N, int G_, int c_) { nM = M / BM; nN = N / BM; nwg = nM * nN; G = G_; c = c_; }
    __host__ __device__ bool next(int i, Unit& u) const {
        const long L = (long)i * G + c; if (L >= nwg) return false;
        int wgid = (int)L; { const int q = nwg / NXCD, r = nwg % NXCD, xcd = wgid % NXCD, off = wgid / NXCD; wgid = (xcd < r ? xcd * (q + 1) : r * (q + 1) + (xcd - r) * q) + off; }
        const int nig = WGM * nN, gid = wgid / nig, fm = gid * WGM, gsz = (nM - fm) < WGM ? (nM - fm) : WGM;
        u.pm = fm + ((wgid % nig) % gsz); u.pn = (wgid % nig) / gsz; u.ko = 0; return true;
    }
    __device__ __forceinline__ void a_ready(const Unit&) const {}
    __device__ __forceinline__ void done(const Unit&) const {}
};

__device__ __forceinline__ unsigned cvt_pk_bf16(float lo, float hi) { unsigned r; asm volatile("v_cvt_pk_bf16_f32 %0, %1, %2" : "=v"(r) : "v"(lo), "v"(hi)); return r; }
typedef float f32x2 __attribute__((ext_vector_type(2)));
typedef __bf16 bf16x2_t __attribute__((ext_vector_type(2)));
__device__ __forceinline__ unsigned pk2(float lo, float hi) { f32x2 v = {lo, hi}; bf16x2_t b = __builtin_convertvector(v, bf16x2_t); return __builtin_bit_cast(unsigned, b); }
struct EpiBf16 {
    static constexpr bool PERM = true, AFTER_DRAIN = false;
    bf16_t* O; int ldc; int act;
    __device__ __forceinline__ void operator()(const f32x4 (&acc)[2][2][4][2], const Unit& u, int wr, int wc, int fr, int fq) const {
        const int row0 = u.pm * BM + wr * 64 + fr; const int col0 = u.pn * BM + wc * 32 + 8 * fq;
#pragma unroll
        for (int ai = 0; ai < 2; ++ai)
#pragma unroll
            for (int m = 0; m < 4; ++m) { bf16_t* rowp = O + (size_t)(row0 + ai * HALF + m * 16) * ldc + col0;
#pragma unroll
                for (int bj = 0; bj < 2; ++bj) { f32x4 v0 = acc[ai][bj][m][0], v1 = acc[ai][bj][m][1];
                    if (act) { const f32x4 z = {0.f, 0.f, 0.f, 0.f}; v0 = __builtin_elementwise_max(v0, z); v1 = __builtin_elementwise_max(v1, z); v0 = v0 * v0; v1 = v1 * v1; }
                    u32x4 w; w.x = pk2(v0[0], v0[1]); w.y = pk2(v0[2], v0[3]); w.z = pk2(v1[0], v1[1]); w.w = pk2(v1[2], v1[3]);
                    *(u32x4*)(rowp + bj * HALF) = w; } }
    }
};
struct EpiRes {
    static constexpr bool PERM = true, AFTER_DRAIN = false;
    const float* base; float* hout; float* dout; int fin;
    __device__ __forceinline__ void operator()(const f32x4 (&acc)[2][2][4][2], const Unit& u, int wr, int wc, int fr, int fq) const {
        const int row0 = u.pm * BM + wr * 64 + fr; const int col0 = u.pn * BM + wc * 32 + 8 * fq;
#pragma unroll
        for (int ai = 0; ai < 2; ++ai)
#pragma unroll
            for (int m = 0; m < 4; ++m) { const int row = row0 + ai * HALF + m * 16; const size_t off = (size_t)row * 1024 + col0;
                const int bb = row / 8320, pp = row - bb * 8320; const size_t ooff = ((size_t)bb * 8192 + (pp - 128)) * 1024 + col0;
#pragma unroll
                for (int bj = 0; bj < 2; ++bj) {
                    const f32x4 r0 = *(const f32x4*)(base + off + bj * HALF) + acc[ai][bj][m][0];
                    const f32x4 r1 = *(const f32x4*)(base + off + bj * HALF + 4) + acc[ai][bj][m][1];
                    if (!fin) { *(f32x4*)(hout + off + bj * HALF) = r0; *(f32x4*)(hout + off + bj * HALF + 4) = r1; }
                    else if (pp >= 128) { *(f32x4*)(dout + ooff + bj * HALF) = r0; *(f32x4*)(dout + ooff + bj * HALF + 4) = r1; } } }
    }
};

struct SplitOrder {
    int S, G, c, kb;
    __host__ __device__ bool next(int i, Unit& u) const { const int L = i * G + c; if (L >= 8 * S) return false; const int ks = L % S, t = L / S; u.pm = t >> 2; u.pn = t & 3; u.ko = ks * kb; return true; }
    __device__ __forceinline__ void a_ready(const Unit&) const {}
    __device__ __forceinline__ void done(const Unit&) const {}
};
struct EpiPart {
    static constexpr bool PERM = true, AFTER_DRAIN = false;
    float* part; int kb;
    __device__ __forceinline__ void operator()(const f32x4 (&acc)[2][2][4][2], const Unit& u, int wr, int wc, int fr, int fq) const {
        const int row0 = u.pm * BM + wr * 64 + fr; const int col0 = u.pn * BM + wc * 32 + 8 * fq; const int ks = u.ko / kb;
#pragma unroll
        for (int ai = 0; ai < 2; ++ai)
#pragma unroll
            for (int m = 0; m < 4; ++m) { float* dst = part + ((size_t)ks * 512 + (row0 + ai * HALF + m * 16)) * 1024 + col0;
#pragma unroll
                for (int bj = 0; bj < 2; ++bj) { *(f32x4*)(dst + bj * HALF) = acc[ai][bj][m][0]; *(f32x4*)(dst + bj * HALF + 4) = acc[ai][bj][m][1]; } }
    }
};
template <class Epi, class Sched, bool ALIGN_EPI = false, bool SP2 = false>
__device__ __forceinline__ void gemm_phase(PG8_LAS unsigned char* lds, const Gemm g, const Sched& S, const Epi& E) {
    const int tid = opaque_tid(), wid = __builtin_amdgcn_readfirstlane(tid >> 6), lane = tid & 63, wr = wid >> 2, wc = wid & 3, fr = lane & 15, fq = lane >> 4;
    const int K = g.K, nt = g.nt;
    unsigned voffA[2], voffB[2];
#pragma unroll
    for (int i = 0; i < 2; ++i) { int R, C; stage_rc(tid * 16 + i * 8192, R, C); const int Rb = Epi::PERM ? ((R & ~31) + perm32(R & 31)) : R;
        voffA[i] = (unsigned)(R * K + C) * 2u; voffB[i] = (unsigned)(Rb * K + C) * 2u; }
    const size_t kstep = (size_t)(BK * 2);
    const size_t hstep = (size_t)HALF * K * 2;
    const size_t tstep = 2 * hstep;
    const unsigned ldsw = (unsigned)wid * 1024u;
    const int aoff = lds_byte(wr * 64 + fr, fq * 8), boff = lds_byte(wc * 32 + fr, fq * 8);
#define PG8_SA(b, h) (((b) * 2 + (h)) * HTB)
#define PG8_SB(b, h) ((4 + (b) * 2 + (h)) * HTB)
#define PG8_STAGE(bufoff, gbase, voff) do { _Pragma("unroll") for (int _i = 0; _i < 2; ++_i) \
        __builtin_amdgcn_global_load_lds((const unsigned*)((const char*)(gbase) + (voff)[_i]), (PG8_LAS unsigned*)(lds + (bufoff) + ldsw + _i * 8192), 16, 0, 0); } while (0)
#define PG8_LDA(dst, b, h) do { _Pragma("unroll") for (int m = 0; m < 4; ++m) _Pragma("unroll") for (int k = 0; k < 2; ++k) dst[m][k] = *(const PG8_LAS bf16x8*)(lds + PG8_SA(b, h) + aoff + m * 2048 + k * 1024); } while (0)
#define PG8_LDB(dst, b, h) do { _Pragma("unroll") for (int n = 0; n < 2; ++n) _Pragma("unroll") for (int k = 0; k < 2; ++k) dst[n][k] = *(const PG8_LAS bf16x8*)(lds + PG8_SB(b, h) + boff + n * 2048 + k * 1024); } while (0)
#define PG8_MMA(ai, bj, At, Bt) do { __builtin_amdgcn_s_setprio(1); _Pragma("unroll") for (int m = 0; m < 4; ++m) _Pragma("unroll") for (int n = 0; n < 2; ++n) _Pragma("unroll") for (int k = 0; k < 2; ++k) \
        acc[ai][bj][m][n] = __builtin_amdgcn_mfma_f32_16x16x32_bf16(Bt[n][k], At[m][k], acc[ai][bj][m][n], 0, 0, 0); __builtin_amdgcn_s_setprio(0); } while (0)
#define PG8_WAIT_V(n) asm volatile("s_waitcnt vmcnt(" #n ")" ::: "memory")
#define PG8_WAIT_L(n) asm volatile("s_waitcnt lgkmcnt(" #n ")" ::: "memory")
#define PG8_BAR __builtin_amdgcn_s_barrier()
#define PG8_SCHED __builtin_amdgcn_sched_barrier(0)
    Unit cur, nxt; int ui = 0;
    if (!S.next(0, cur)) return;
    f32x4 acc[2][2][4][2];
#pragma unroll
    for (int a = 0; a < 2; ++a)
#pragma unroll
        for (int b = 0; b < 2; ++b)
#pragma unroll
            for (int m = 0; m < 4; ++m)
#pragma unroll
                for (int n = 0; n < 2; ++n) acc[a][b][m][n] = (f32x4){0.f, 0.f, 0.f, 0.f};
    bf16x8 At[4][2], B0[2][2], B1[2][2];
    const char* cA = (const char*)g.A + (size_t)cur.pm * tstep + cur.ko; const char* cB = (const char*)g.Bt + (size_t)cur.pn * tstep + cur.ko;
    S.a_ready(cur);
    if constexpr (SP2) {
        PG8_STAGE(PG8_SB(0, 0), cB, voffB); PG8_STAGE(PG8_SB(0, 1), cB + hstep, voffB); PG8_STAGE(PG8_SA(0, 0), cA, voffA); PG8_STAGE(PG8_SA(0, 1), cA + hstep, voffA);
        if (wr == 1) PG8_BAR;
        PG8_WAIT_V(2); PG8_BAR;
        PG8_STAGE(PG8_SB(1, 0), cB + kstep, voffB); PG8_STAGE(PG8_SA(1, 0), cA + kstep, voffA); PG8_STAGE(PG8_SB(1, 1), cB + hstep + kstep, voffB);
        PG8_WAIT_V(6); PG8_BAR;
    } else {
        PG8_STAGE(PG8_SB(0, 0), cB, voffB); PG8_STAGE(PG8_SA(0, 0), cA, voffA); PG8_STAGE(PG8_SB(0, 1), cB + hstep, voffB); PG8_STAGE(PG8_SA(0, 1), cA + hstep, voffA);
        if (wr == 1) PG8_BAR;
        PG8_WAIT_V(4); PG8_BAR;
        PG8_STAGE(PG8_SB(1, 0), cB + kstep, voffB); PG8_STAGE(PG8_SA(1, 0), cA + kstep, voffA); PG8_STAGE(PG8_SB(1, 1), cB + hstep + kstep, voffB);
        PG8_WAIT_V(6); PG8_BAR;
    }
    for (;;) {
        const bool has_next = S.next(ui + 1, nxt);
        const char* nA = has_next ? (const char*)g.A + (size_t)nxt.pm * tstep + nxt.ko : cA; const char* nB = has_next ? (const char*)g.Bt + (size_t)nxt.pn * tstep + nxt.ko : cB;
        for (int t = 0; t < nt; t += 2) {
            const bool last = (t == nt - 2);
            const char* a1 = cA + (size_t)(t + 1) * kstep;
            const char* a2 = last ? nA : cA + (size_t)(t + 2) * kstep; const char* b2 = last ? nB : cB + (size_t)(t + 2) * kstep;
            const char* a3 = a2 + kstep; const char* b3 = b2 + kstep;
            if (last && has_next) S.a_ready(nxt);
            if constexpr (SP2) {
            PG8_LDB(B0, 0, 0); PG8_LDB(B1, 0, 1); PG8_SCHED; PG8_LDA(At, 0, 0); PG8_STAGE(PG8_SA(1, 1), a1 + hstep, voffA);
            PG8_WAIT_V(8); PG8_WAIT_L(0); PG8_BAR; PG8_MMA(0, 0, At, B0); PG8_MMA(0, 1, At, B1); PG8_BAR; PG8_SCHED;
            PG8_LDA(At, 0, 1); PG8_STAGE(PG8_SB(0, 0), b2, voffB); PG8_STAGE(PG8_SB(0, 1), b2 + hstep, voffB); PG8_STAGE(PG8_SA(0, 0), a2, voffA);
            PG8_WAIT_V(8); PG8_WAIT_L(0); PG8_BAR; PG8_MMA(1, 0, At, B0); PG8_MMA(1, 1, At, B1); PG8_BAR; PG8_SCHED;
            PG8_LDB(B0, 1, 0); PG8_LDB(B1, 1, 1); PG8_SCHED; PG8_LDA(At, 1, 0); PG8_STAGE(PG8_SA(0, 1), a2 + hstep, voffA);
            PG8_WAIT_V(8); PG8_WAIT_L(0); PG8_BAR; PG8_MMA(0, 0, At, B0); PG8_MMA(0, 1, At, B1); PG8_BAR; PG8_SCHED;
            PG8_LDA(At, 1, 1); PG8_STAGE(PG8_SB(1, 0), b3, voffB); PG8_STAGE(PG8_SB(1, 1), b3 + hstep, voffB); PG8_STAGE(PG8_SA(1, 0), a3, voffA);
            PG8_WAIT_V(8); PG8_WAIT_L(0); PG8_BAR; PG8_MMA(1, 0, At, B0); PG8_MMA(1, 1, At, B1); PG8_BAR; PG8_SCHED;
            } else {
            PG8_LDB(B0, 0, 0); PG8_SCHED; PG8_LDA(At, 0, 0); PG8_STAGE(PG8_SA(1, 1), a1 + hstep, voffA);
            PG8_WAIT_L(8); PG8_BAR; PG8_WAIT_L(0); PG8_MMA(0, 0, At, B0); PG8_BAR; PG8_SCHED;
            PG8_LDB(B1, 0, 1); PG8_STAGE(PG8_SB(0, 0), b2, voffB);
            PG8_BAR; PG8_WAIT_L(0); PG8_MMA(0, 1, At, B1); PG8_BAR;
            PG8_LDA(At, 0, 1); PG8_STAGE(PG8_SA(0, 0), a2, voffA);
            PG8_BAR; PG8_WAIT_L(0); PG8_MMA(1, 0, At, B0); PG8_BAR; PG8_SCHED;
            PG8_STAGE(PG8_SB(0, 1), b2 + hstep, voffB);
            PG8_WAIT_V(6); PG8_BAR; PG8_MMA(1, 1, At, B1); PG8_BAR;
            PG8_LDB(B0, 1, 0); PG8_SCHED; PG8_LDA(At, 1, 0); PG8_STAGE(PG8_SA(0, 1), a2 + hstep, voffA);
            PG8_WAIT_L(8); PG8_BAR; PG8_WAIT_L(0); PG8_MMA(0, 0, At, B0); PG8_BAR; PG8_SCHED;
            PG8_LDB(B1, 1, 1); PG8_STAGE(PG8_SB(1, 0), b3, voffB);
            PG8_BAR; PG8_WAIT_L(0); PG8_MMA(0, 1, At, B1); PG8_BAR;
            PG8_LDA(At, 1, 1); PG8_STAGE(PG8_SA(1, 0), a3, voffA);
            PG8_BAR; PG8_WAIT_L(0); PG8_MMA(1, 0, At, B0); PG8_BAR; PG8_SCHED;
            PG8_STAGE(PG8_SB(1, 1), b3 + hstep, voffB);
            PG8_WAIT_V(6); PG8_BAR; PG8_MMA(1, 1, At, B1); PG8_BAR;
            }
        }
        if constexpr (ALIGN_EPI) { if (wr == 0) PG8_BAR; }
        if constexpr (!Epi::AFTER_DRAIN) { E(acc, cur, wr, wc, fr, fq); S.done(cur); }
        if (!has_next) break;
#pragma unroll
        for (int a = 0; a < 2; ++a)
#pragma unroll
            for (int b = 0; b < 2; ++b)
#pragma unroll
                for (int m = 0; m < 4; ++m)
#pragma unroll
                    for (int n = 0; n < 2; ++n) acc[a][b][m][n] = (f32x4){0.f, 0.f, 0.f, 0.f};
        cur = nxt; cA = nA; cB = nB; ++ui;
        if constexpr (ALIGN_EPI) { if (wr == 1) PG8_BAR; }
    }
    PG8_WAIT_V(0);
    if constexpr (!ALIGN_EPI) { if (wr == 0) PG8_BAR; }
    PG8_BAR;
    if constexpr (Epi::AFTER_DRAIN) { E.fused(acc, cur, wr, wc, fr, fq, lds, wid, lane); S.done(cur); }
#undef PG8_SA
#undef PG8_SB
#undef PG8_STAGE
#undef PG8_LDA
#undef PG8_LDB
#undef PG8_MMA
#undef PG8_WAIT_V
#undef PG8_WAIT_L
#undef PG8_BAR
#undef PG8_SCHED
}
}
typedef unsigned short bf16_t;
typedef short bf16x8 __attribute__((ext_vector_type(8)));
typedef short s16x4 __attribute__((ext_vector_type(4)));
typedef float f32x4 __attribute__((ext_vector_type(4)));
typedef float f32x16 __attribute__((ext_vector_type(16)));
typedef unsigned u32x4 __attribute__((ext_vector_type(4)));
using pg8::pk2;
constexpr int NB = 4, LP = 8320, PADF = 112, RT = NB * LP;
constexpr int DM = 1024, ZW = 2304, ZCW = 3072, FF = 4096;
constexpr float EPSN = 1e-6f;
constexpr float QS_MLA = 0.14724444602590306f, QS_FOX = 0.18033688011112042f, LOG2E = 1.4426950408889634f;
constexpr size_t W_INATTN = 0, W_UQ = W_INATTN + 2ull * 2304 * 1024 * 2, W_UKV = W_UQ + 2ull * 768 * 384 * 2, W_OUTATTN = W_UKV + 2ull * 1024 * 256 * 2,
    W_INCONV = W_OUTATTN + 2ull * 1024 * 1024 * 2, W_OUTCONV = W_INCONV + 2ull * 3072 * 1024 * 2, W_UP = W_OUTCONV + 2ull * 1024 * 1024 * 2, W_DOWN = W_UP + 4ull * 4096 * 1024 * 2,
    WS_H = W_DOWN + 4ull * 4096 * 1024 * 2, WS_T = WS_H + (size_t)RT * 1024 * 4, WS_KR = WS_T + (size_t)RT * 4096 * 2, WS_END = WS_KR + (size_t)RT * 256 * 2;
constexpr size_t T_Z = 0, T_QRAW = (size_t)RT * ZW * 2, T_KVRAW = T_QRAW + (size_t)RT * 768 * 2, T_YB = (size_t)RT * ZCW * 2;
constexpr size_t O_HN = 0, O_CQN = (size_t)RT * 1024 * 2, O_CKVN = O_CQN + (size_t)RT * 384 * 2, O_LOGF = O_CKVN + (size_t)RT * 256 * 2, O_CUM = O_LOGF + (size_t)RT * 8 * 4, O_END = O_CUM + (size_t)RT * 8 * 4;
constexpr size_t WS_BAR = (WS_END + 255) & ~(size_t)255, WS_BAR_BYTES = 16384;
static_assert(WS_BAR + WS_BAR_BYTES <= 536870912ull && O_END <= 134217728ull, "scratch maps");

__device__ __forceinline__ float bflo(unsigned u) { return __uint_as_float(u << 16); }
__device__ __forceinline__ float bfhi(unsigned u) { return __uint_as_float(u & 0xffff0000u); }
__device__ __forceinline__ void unpack8(const u32x4 w, float (&f)[8]) { f[0] = bflo(w.x); f[1] = bfhi(w.x); f[2] = bflo(w.y); f[3] = bfhi(w.y); f[4] = bflo(w.z); f[5] = bfhi(w.z); f[6] = bflo(w.w); f[7] = bfhi(w.w); }
__device__ __forceinline__ u32x4 pack8(const float (&f)[8]) { u32x4 w; w.x = pk2(f[0], f[1]); w.y = pk2(f[2], f[3]); w.z = pk2(f[4], f[5]); w.w = pk2(f[6], f[7]); return w; }
__device__ __forceinline__ float wave_sum(float v) {
#pragma unroll
    for (int o = 1; o < 64; o <<= 1) v += __shfl_xor(v, o);
    return v;
}
__device__ __forceinline__ float grp8_sum(float v) { v += __shfl_xor(v, 1); v += __shfl_xor(v, 2); v += __shfl_xor(v, 4); return v; }

namespace att {
constexpr int KB_MAX = 12288, VBY = 8192, FBY = 256, BUF = KB_MAX + VBY + FBY;
constexpr int LDS_WS = 2 * BUF, LDS_OST = LDS_WS + 8 * 256, LDS_BYTES = LDS_OST + 8 * 4096;
constexpr float NEG = -1e30f;
__device__ __forceinline__ int crow(int r, int hi) { return (r & 3) + 8 * (r >> 2) + 4 * hi; }
__device__ __forceinline__ float max3f(float a, float b, float c) { float r; asm("v_max3_f32 %0, %1, %2, %3" : "=v"(r) : "v"(a), "v"(b), "v"(c)); return r; }
__device__ __forceinline__ float max2f(float a, float b) { float r; asm("v_max_f32_e32 %0, %1, %2" : "=v"(r) : "v"(a), "v"(b)); return r; }
typedef __attribute__((address_space(3))) const char* lds_cptr;
typedef short v4i16_t __attribute__((ext_vector_type(4)));
__device__ __forceinline__ s16x4 vtr(lds_cptr p) { return __builtin_bit_cast(s16x4, __builtin_amdgcn_ds_read_tr16_b64_v4i16((__attribute__((address_space(3))) v4i16_t*)p)); }
__device__ __forceinline__ void pv(f32x16* o, int vb, bf16x8 pa0, bf16x8 pa1, bf16x8 pa2, bf16x8 pa3) {
#pragma unroll
    for (int d0 = 0; d0 < 2; ++d0) { s16x4 lo[4], hi[4];
#pragma unroll
        for (int ks = 0; ks < 4; ++ks) {
            asm volatile("ds_read_b64_tr_b16 %0,%1 offset:%c2" : "=&v"(lo[ks]) : "v"(vb), "i"(d0 * 4096 + ks * 1024) : "memory");
            asm volatile("ds_read_b64_tr_b16 %0,%1 offset:%c2" : "=&v"(hi[ks]) : "v"(vb), "i"(d0 * 4096 + ks * 1024 + 512) : "memory"); }
        asm volatile("s_waitcnt lgkmcnt(0)" ::: "memory"); __builtin_amdgcn_sched_barrier(0);
#define PK(k) (bf16x8){lo[k][0], lo[k][1], lo[k][2], lo[k][3], hi[k][0], hi[k][1], hi[k][2], hi[k][3]}
        o[d0] = __builtin_amdgcn_mfma_f32_32x32x16_bf16(pa0, PK(0), o[d0], 0, 0, 0);
        o[d0] = __builtin_amdgcn_mfma_f32_32x32x16_bf16(pa1, PK(1), o[d0], 0, 0, 0);
        o[d0] = __builtin_amdgcn_mfma_f32_32x32x16_bf16(pa2, PK(2), o[d0], 0, 0, 0);
        o[d0] = __builtin_amdgcn_mfma_f32_32x32x16_bf16(pa3, PK(3), o[d0], 0, 0, 0);
#undef PK
    }
}
template <bool FOX> __device__ __forceinline__ void attn_unit(const bf16_t* __restrict__ Qp, int qpitch, const bf16_t* __restrict__ Kp, int kpitch, const bf16_t* __restrict__ KRp,
                                                              const bf16_t* __restrict__ Vp, int vpitch, bf16_t* Op, const float* __restrict__ F2, float fbound, int qblk, char* shm) {
    constexpr int DK = FOX ? 64 : 96, ND0 = DK / 16;
    const int tid = opaque_tid(), lane = tid & 63, r32 = lane & 31, hi = lane >> 5; const int wid = __builtin_amdgcn_readfirstlane(tid >> 6);
    const bool tiny = qblk < 0;
    const int q0 = tiny ? 0 : 128 + 256 * qblk;
    const int jend = tiny ? 1 : (q0 + 256) / 64 - 1;
    const int qw0 = q0 + 32 * wid, qrow = qw0 + r32;
    bf16x8 qr[ND0];
#pragma unroll
    for (int d0 = 0; d0 < ND0; ++d0) qr[d0] = *(const bf16x8*)(Qp + (size_t)qrow * qpitch + d0 * 16 + hi * 8);
    float fq2 = 0.f; if (FOX) fq2 = F2[qrow];
    float* wsf = (float*)(shm + LDS_WS) + wid * 64;
    const unsigned lds0 = (unsigned)(uintptr_t)shm;
    const int vlane = ((lane >> 4) & 1) * 32 + (lane & 3) * 8 + (4 * hi + ((lane & 15) >> 2)) * 64;
    u32x4 kreg = {0, 0, 0, 0}, krreg = {0, 0, 0, 0}, vreg = {0, 0, 0, 0}; float freg = 0.f;
#define ATT_LOAD(j) do { const int kv0_ = 64 * (j); \
        kreg = *(const u32x4*)(Kp + (size_t)(kv0_ + lane) * kpitch + wid * 8); \
        if (!FOX && wid < 4) krreg = *(const u32x4*)(KRp + (size_t)(kv0_ + lane) * 256 + wid * 8); \
        vreg = *(const u32x4*)(Vp + (size_t)(kv0_ + 16 * (wid & 3) + (lane >> 2)) * vpitch + (wid >> 2) * 32 + (lane & 3) * 8); \
        if (FOX && wid == 0) freg = F2[kv0_ + lane]; } while (0)
#define ATT_STORE(buf) do { char* b_ = shm + (buf) * BUF; \
        *(u32x4*)(b_ + wid * 1024 + lane * 16) = kreg; \
        if (!FOX && wid < 4) *(u32x4*)(b_ + (8 + wid) * 1024 + lane * 16) = krreg; \
        *(u32x4*)(b_ + KB_MAX + wid * 1024 + lane * 16) = vreg; \
        if (FOX && wid == 0) *(float*)(b_ + KB_MAX + VBY + lane * 4) = freg; } while (0)
    float m_run = 0.f, l_run = 0.f; f32x16 o[2]; o[0] = f32x16{}; o[1] = f32x16{};
    f32x16 negm = f32x16{};
    int jstart = 1;
    if (FOX && !tiny) { const int jj = tid + 1; const bool sk = jj <= jend && (F2[q0] - F2[64 * (jj <= jend ? jj : jend) + 63] + fbound < -175.0f); jstart = 1 + __syncthreads_count(sk ? 1 : 0); if (jstart > jend) jstart = jend; }
    ATT_LOAD(jstart); ATT_STORE(0); __syncthreads();
#define VFR(i) __builtin_shufflevector(vlo[i], vhi[i], 0, 1, 2, 3, 4, 5, 6, 7)
#define ATT_BODY(MASKED, PADM) do { \
        const int buf = (j - jstart) & 1; \
        if (j < jend) ATT_LOAD(j + 1); \
        const int kv0 = 64 * j; \
        if (!(MASKED) || kv0 <= qw0 + 31) { \
            const char* Kb = shm + buf * BUF; \
            const lds_cptr vp = (lds_cptr)shm + buf * BUF + KB_MAX + vlane; \
            s16x4 vlo[8], vhi[8]; \
        _Pragma("unroll") \
            for (int i = 0; i < 8; ++i) { vlo[i] = vtr(vp + (i >> 2) * 4096 + (i & 3) * 1024); vhi[i] = vtr(vp + (i >> 2) * 4096 + (i & 3) * 1024 + 512); } \
            f32x16 p0, p1; \
            if (FOX) { const float* fb = (const float*)(Kb + KB_MAX + VBY); const float fqm = fq2 - m_run; \
        _Pragma("unroll") \
                for (int g = 0; g < 4; ++g) { const f32x4 a = *(const f32x4*)(fb + 8 * g + 4 * hi), b = *(const f32x4*)(fb + 32 + 8 * g + 4 * hi); \
        _Pragma("unroll") \
                    for (int i = 0; i < 4; ++i) { p0[4 * g + i] = fqm - a[i]; p1[4 * g + i] = fqm - b[i]; } } \
            } else { p0 = negm; p1 = negm; } \
            const char* kb = Kb + hi * 1024 + r32 * 16; \
        _Pragma("unroll") \
            for (int d0 = 0; d0 < ND0; ++d0) { const bf16x8 b0 = *(const bf16x8*)(kb + d0 * 2048), b1 = *(const bf16x8*)(kb + d0 * 2048 + 512); \
                p0 = __builtin_amdgcn_mfma_f32_32x32x16_bf16(b0, qr[d0], p0, 0, 0, 0); p1 = __builtin_amdgcn_mfma_f32_32x32x16_bf16(b1, qr[d0], p1, 0, 0, 0); } \
            if (MASKED) { const int dq_ = qrow - kv0 - 4 * hi; \
        _Pragma("unroll") \
                for (int r = 0; r < 16; ++r) { const int c_ = (r & 3) + 8 * (r >> 2); if (c_ > dq_) p0[r] = NEG; if (c_ + 32 > dq_) p1[r] = NEG; } \
                if (PADM) { const int dp_ = PADF - kv0 - 4 * hi; \
        _Pragma("unroll") \
                for (int r = 0; r < 16; ++r) { const int c_ = (r & 3) + 8 * (r >> 2); if (c_ < dp_) p0[r] = NEG; if (c_ + 32 < dp_) p1[r] = NEG; } } \
            } \
            float rm, rm2; { rm = max3f(p0[0], p0[1], p1[0]); rm2 = max3f(p0[2], p0[3], p1[1]); rm = max3f(rm, p1[2], p1[3]); \
              _Pragma("unroll") for (int r = 4; r < 16; r += 4) { rm = max3f(rm, p0[r], p0[r + 1]); rm2 = max3f(rm2, p0[r + 2], p0[r + 3]); rm = max3f(rm, p1[r], p1[r + 1]); rm2 = max3f(rm2, p1[r + 2], p1[r + 3]); } \
              rm = max2f(rm, rm2); } \
            { auto rr = __builtin_amdgcn_permlane32_swap(__float_as_uint(rm), __float_as_uint(rm), false, false); rm = max2f(__uint_as_float(rr[0]), __uint_as_float(rr[1])); } \
            if (__any(rm > 8.0f)) { \
                const float dl = fmaxf(rm, 0.f); const float f = __builtin_amdgcn_exp2f(-dl); m_run += dl; l_run *= f; \
        _Pragma("unroll") \
                for (int r = 0; r < 16; ++r) { p0[r] -= dl; p1[r] -= dl; negm[r] = -m_run; } \
                if (hi == 0) wsf[r32] = f; \
                asm volatile("s_waitcnt lgkmcnt(0)" ::: "memory"); \
        _Pragma("unroll") \
                for (int r = 0; r < 16; ++r) { const float fac = wsf[crow(r, hi)]; o[0][r] *= fac; o[1][r] *= fac; } \
                asm volatile("s_waitcnt lgkmcnt(0)" ::: "memory"); \
            } \
            float sacc = 0.f; \
        _Pragma("unroll") \
            for (int r = 0; r < 16; ++r) { p0[r] = __builtin_amdgcn_exp2f(p0[r]); p1[r] = __builtin_amdgcn_exp2f(p1[r]); sacc += p0[r] + p1[r]; } \
            l_run += sacc; \
            u32x4 pw0, pw1, pw2, pw3; \
            pw0 = (u32x4){pk2(p0[0], p0[1]), pk2(p0[2], p0[3]), pk2(p0[4], p0[5]), pk2(p0[6], p0[7])}; \
            pw1 = (u32x4){pk2(p0[8], p0[9]), pk2(p0[10], p0[11]), pk2(p0[12], p0[13]), pk2(p0[14], p0[15])}; \
            pw2 = (u32x4){pk2(p1[0], p1[1]), pk2(p1[2], p1[3]), pk2(p1[4], p1[5]), pk2(p1[6], p1[7])}; \
            pw3 = (u32x4){pk2(p1[8], p1[9]), pk2(p1[10], p1[11]), pk2(p1[12], p1[13]), pk2(p1[14], p1[15])}; \
            o[0] = __builtin_amdgcn_mfma_f32_32x32x16_bf16(__builtin_bit_cast(bf16x8, pw0), VFR(0), o[0], 0, 0, 0); \
            o[1] = __builtin_amdgcn_mfma_f32_32x32x16_bf16(__builtin_bit_cast(bf16x8, pw0), VFR(4), o[1], 0, 0, 0); \
            o[0] = __builtin_amdgcn_mfma_f32_32x32x16_bf16(__builtin_bit_cast(bf16x8, pw1), VFR(1), o[0], 0, 0, 0); \
            o[1] = __builtin_amdgcn_mfma_f32_32x32x16_bf16(__builtin_bit_cast(bf16x8, pw1), VFR(5), o[1], 0, 0, 0); \
            o[0] = __builtin_amdgcn_mfma_f32_32x32x16_bf16(__builtin_bit_cast(bf16x8, pw2), VFR(2), o[0], 0, 0, 0); \
            o[1] = __builtin_amdgcn_mfma_f32_32x32x16_bf16(__builtin_bit_cast(bf16x8, pw2), VFR(6), o[1], 0, 0, 0); \
            o[0] = __builtin_amdgcn_mfma_f32_32x32x16_bf16(__builtin_bit_cast(bf16x8, pw3), VFR(3), o[0], 0, 0, 0); \
            o[1] = __builtin_amdgcn_mfma_f32_32x32x16_bf16(__builtin_bit_cast(bf16x8, pw3), VFR(7), o[1], 0, 0, 0); \
        } \
        if (j < jend) ATT_STORE(buf ^ 1); \
        __syncthreads(); \
    } while (0)
    const int jdiag = jend - 3;
    int j = jstart;
    if (j == 1) { ATT_BODY(true, true); ++j; }
    for (; j < jdiag; ++j) { ATT_BODY(false, false); }
    for (; j <= jend; ++j) { ATT_BODY(true, false); }
#undef ATT_BODY
#undef VFR
#undef ATT_LOAD
#undef ATT_STORE
    { auto rr = __builtin_amdgcn_permlane32_swap(__float_as_uint(l_run), __float_as_uint(l_run), false, false); l_run = __uint_as_float(rr[0]) + __uint_as_float(rr[1]); }
    if (hi == 0) wsf[32 + r32] = l_run;
    asm volatile("s_waitcnt lgkmcnt(0)" ::: "memory");
    float rli[16];
#pragma unroll
    for (int r = 0; r < 16; ++r) rli[r] = __builtin_amdgcn_rcpf(wsf[32 + crow(r, hi)]);
    bf16_t* stg = (bf16_t*)(shm + LDS_OST) + wid * 2048;
#pragma unroll
    for (int r = 0; r < 16; ++r) { const int orow = crow(r, hi);
#pragma unroll
        for (int d0 = 0; d0 < 2; ++d0) stg[orow * 64 + d0 * 32 + r32] = (bf16_t)(pk2(o[d0][r] * rli[r], 0.f) & 0xffffu); }
    asm volatile("s_waitcnt lgkmcnt(0)" ::: "memory");
#pragma unroll
    for (int i = 0; i < 4; ++i) { const int row = i * 8 + (lane >> 3), ch = lane & 7; u32x4 v = *(const u32x4*)(stg + row * 64 + ch * 8);
        const int grow = qw0 + row;
        if (tiny) { if (grow >= 128) continue; if (grow < PADF) v = (u32x4){0, 0, 0, 0}; }
        *(u32x4*)(Op + (size_t)grow * 1024 + ch * 8) = v; }
    asm volatile("s_waitcnt lgkmcnt(0)" ::: "memory");
}
}
#define LAS __attribute__((address_space(3)))
#define XB_TMO      128
#define XB_XCNT(j)  (256  + 64 * (j))
#define XB_XSUB(j)  (1280 + 64 * (j))
#define XB_XGEN(j)  (2304 + 64 * (j))
#define XB_TOP      3328
#define XB_TOPGEN   3392
#define XCD_BAR_WORDS 3456
#define XB_SPIN_CAP (1u << 18)

__device__ __forceinline__ unsigned xb_ld(unsigned* p)              { return __hip_atomic_load(p, __ATOMIC_RELAXED, __HIP_MEMORY_SCOPE_AGENT); }
__device__ __forceinline__ unsigned xb_add(unsigned* p, unsigned v) { return __hip_atomic_fetch_add(p, v, __ATOMIC_RELAXED, __HIP_MEMORY_SCOPE_AGENT); }
__device__ __forceinline__ unsigned xb_xcc_id() { return (unsigned)__builtin_amdgcn_s_getreg((3 << 11) | 20) & 0xFu; }
#define XB_SPIN(cond, bar) do { unsigned _sp = 0; while (cond) { __builtin_amdgcn_s_sleep(1); \
    if ((++_sp & 255u) == 0u) { if (xb_ld(&(bar)[XB_TMO])) break; if (_sp > XB_SPIN_CAP) { atomicAdd(&(bar)[XB_TMO], 1u); break; } } } } while (0)

struct XcdBarrier {
    unsigned* bar; unsigned x;
    volatile LAS unsigned* st;
};

__device__ __forceinline__ XcdBarrier xcd_barrier_post(unsigned* bar, volatile LAS unsigned* st) {
    XcdBarrier b; b.bar = bar; b.x = xb_xcc_id(); b.st = st;
    if (threadIdx.x == 0) (void)xb_add(&bar[XB_XCNT(b.x)], 1u);
    return b;
}
__device__ __forceinline__ void xcd_barrier_complete(unsigned* bar, unsigned x, unsigned& nloc, unsigned& nx) {
    const unsigned G = gridDim.x * gridDim.y * gridDim.z;
    unsigned sum, cnt, mine, sp = 0u;
    for (;;) {
        sum = 0u; cnt = 0u; mine = 0u;
#pragma unroll
        for (unsigned j = 0; j < 16; ++j) { const unsigned c = xb_ld(&bar[XB_XCNT(j)]); sum += c; cnt += (c > 0u) ? 1u : 0u; mine = (j == x) ? c : mine; }
        if (sum == G) break;
        __builtin_amdgcn_s_sleep(1);
        if ((++sp & 255u) == 0u) { if (xb_ld(&bar[XB_TMO])) break; if (sp > XB_SPIN_CAP) { atomicAdd(&bar[XB_TMO], 1u); break; } }
    }
    nloc = mine > 0u ? mine : 1u; nx = cnt > 0u ? cnt : 1u;
}

__device__ __forceinline__ void xcd_barrier(const XcdBarrier& b) {
    asm volatile("s_waitcnt vmcnt(0)" ::: "memory");
    __syncthreads();
    if (threadIdx.x == 0) {
        unsigned* bar = b.bar;
        __builtin_amdgcn_s_waitcnt(0);
        unsigned nloc = b.st[0], nx = b.st[1];
        if (nloc == 0u) { xcd_barrier_complete(bar, b.x, nloc, nx); b.st[0] = nloc; b.st[1] = nx; }
        const unsigned old = xb_add(&bar[XB_XSUB(b.x)], 1u);
        const unsigned gen = old / nloc;
        if (old + 1u == (gen + 1u) * nloc) {
            __builtin_amdgcn_fence(__ATOMIC_RELEASE, "agent");
            asm volatile("s_waitcnt vmcnt(0)" ::: "memory");
            const unsigned og = xb_add(&bar[XB_TOP], 1u);
            const unsigned tg = og / nx;
            if (og + 1u == (tg + 1u) * nx) xb_add(&bar[XB_TOPGEN], 1u);
            else XB_SPIN(xb_ld(&bar[XB_TOPGEN]) == tg, bar);
            __builtin_amdgcn_fence(__ATOMIC_ACQUIRE, "agent");
            xb_add(&bar[XB_XGEN(b.x)], 1u);
            asm volatile("s_waitcnt vmcnt(0)" ::: "memory");
        } else {
            XB_SPIN(xb_ld(&bar[XB_XGEN(b.x)]) == gen, bar);
            __builtin_amdgcn_fence(__ATOMIC_ACQUIRE, "agent");
            asm volatile("s_waitcnt vmcnt(0)" ::: "memory");
        }
    }
    __syncthreads();
}

struct Params { const float* in[20]; float* out; unsigned char* ws; };
constexpr int NWAVES = 8, NTHR = 512;
constexpr int LDS_BYTES = 135168;

__device__ __forceinline__ void transpose_item(const float* __restrict__ W, int K, int N, int Npad, bf16_t* __restrict__ WT, float* scr, int item, int lane) {
    const int nblk = Npad / 32, kb = item / nblk, nb = item - kb * nblk, k0 = 64 * kb, n0 = 32 * nb;
    const int nn = n0 + (lane & 31); const bool ok = nn < N;
#pragma unroll 8
    for (int i = 0; i < 32; ++i) { const int kk = 2 * i + (lane >> 5); scr[kk * 33 + (lane & 31)] = ok ? __builtin_nontemporal_load(W + (size_t)(k0 + kk) * N + nn) : 0.f; }
    asm volatile("s_waitcnt lgkmcnt(0)" ::: "memory");
    const int c = lane & 7;
#pragma unroll
    for (int j = 0; j < 4; ++j) { const int n = (lane >> 3) + 8 * j; const float* s = scr + (8 * c) * 33 + n;
        u32x4 o; o.x = pk2(s[0 * 33], s[1 * 33]); o.y = pk2(s[2 * 33], s[3 * 33]); o.z = pk2(s[4 * 33], s[5 * 33]); o.w = pk2(s[6 * 33], s[7 * 33]);
        *(u32x4*)(WT + (size_t)(n0 + n) * K + k0 + 8 * c) = o; }
    asm volatile("s_waitcnt lgkmcnt(0)" ::: "memory");
}
__device__ __forceinline__ void norm_store(const f32x4 (&v)[4], const float* __restrict__ g, bf16_t* orow, int lane) {
    float s = 0.f;
#pragma unroll
    for (int j = 0; j < 4; ++j) s += (v[j].x * v[j].x + v[j].y * v[j].y) + (v[j].z * v[j].z + v[j].w * v[j].w);
    const float rstd = __builtin_amdgcn_rsqf(wave_sum(s) * (1.f / 1024.f) + EPSN);
    unsigned long long* o8 = (unsigned long long*)orow + lane;
#pragma unroll
    for (int j = 0; j < 4; ++j) { const f32x4 gg = *((const f32x4*)g + lane + 64 * j);
        o8[64 * j] = (unsigned long long)pk2(v[j].x * rstd * gg.x, v[j].y * rstd * gg.y) | ((unsigned long long)pk2(v[j].z * rstd * gg.z, v[j].w * rstd * gg.w) << 32); }
}
__device__ __forceinline__ float log_sigmoid(float x) { return fminf(x, 0.f) - log1pf(__expf(-fabsf(x))); }

__device__ __forceinline__ double invf_rev(int i) {
    switch (i) { case 0: return 0.15915494309189535; case 1: return 0.08949940160889101; case 2: return 0.050329212104487035; case 3: return 0.0283021958306234;
        case 4: return 0.015915494309189534; case 5: return 0.008949940160889102; case 6: return 0.005032921210448704; case 7: return 0.00283021958306234;
        case 8: return 0.0015915494309189536; case 9: return 0.0008949940160889102; case 10: return 0.0005032921210448703; case 11: return 0.00028302195830623395;
        case 12: return 0.00015915494309189535; case 13: return 8.949940160889102e-05; case 14: return 5.0329212104487035e-05; default: return 2.8302195830623396e-05; }
}

__global__ void __launch_bounds__(NTHR) fwd_megakernel(Params P) {
    extern __shared__ __attribute__((aligned(16))) unsigned char lds[];
    cg::grid_group grid = cg::this_grid();
    volatile LAS unsigned* bst = (volatile LAS unsigned*)((LAS unsigned char*)lds + 134144);
    if (threadIdx.x == 0) { bst[0] = 0u; bst[1] = 0u; }
    if (blockIdx.x == 0) { unsigned* bw = (unsigned*)(P.ws + WS_BAR); for (int i = threadIdx.x; i < (int)(WS_BAR_BYTES / 4); i += NTHR) __hip_atomic_store(bw + i, 0u, __ATOMIC_RELAXED, __HIP_MEMORY_SCOPE_AGENT); }
    grid.sync();
    const XcdBarrier xbar = xcd_barrier_post((unsigned*)(P.ws + WS_BAR), bst);
    const int G = gridDim.x, bx = blockIdx.x, NGW = G * NWAVES;
#define LANE_SETUP() const int tid = opaque_tid(), lane = tid & 63, wave = __builtin_amdgcn_readfirstlane(tid >> 6); const int gw = bx * NWAVES + wave; (void)gw; (void)lane
    unsigned char* ws = P.ws; unsigned char* ob = (unsigned char*)P.out;
    float* H = (float*)(ws + WS_H);
    bf16_t* HN = (bf16_t*)(ob + O_HN); bf16_t* OB = HN;
    bf16_t* CQN = (bf16_t*)(ob + O_CQN); bf16_t* CKVN = (bf16_t*)(ob + O_CKVN);
    float* LOGF = (float*)(ob + O_LOGF); float* CUM = (float*)(ob + O_CUM);
    bf16_t* Z = (bf16_t*)(ws + WS_T + T_Z); bf16_t* QRAW = (bf16_t*)(ws + WS_T + T_QRAW); bf16_t* KVRAW = (bf16_t*)(ws + WS_T + T_KVRAW);
    bf16_t* ZC = (bf16_t*)(ws + WS_T); bf16_t* YB = (bf16_t*)(ws + WS_T + T_YB); bf16_t* HID = (bf16_t*)(ws + WS_T);
    bf16_t* KR = (bf16_t*)(ws + WS_KR);

    {
        LANE_SETUP();
        float* scr = (float*)(lds + wave * 8448);
        constexpr int I0 = 16 * 72, I1 = 6 * 24, I2 = 4 * 32, I3 = 16 * 32, I4 = 16 * 96, I5 = 16 * 32, I6 = 16 * 128, I7 = 64 * 32;
        constexpr int C0 = 2 * I0, C1 = C0 + 2 * I1, C2 = C1 + 2 * I2, C3 = C2 + 2 * I3, C4 = C3 + 2 * I4, C5 = C4 + 2 * I5, C6 = C5 + 4 * I6, C7 = C6 + 4 * I7;
        for (int it = gw; it < C7; it += NGW) {
            const float* src; bf16_t* dst; int K, N, Np, r;
            if (it < C0) { const int j = it / I0; r = it - j * I0; K = 1024; N = 2216; Np = 2304; src = P.in[4] + (size_t)j * 1024 * 2216; dst = (bf16_t*)(ws + W_INATTN) + (size_t)j * 2304 * 1024; }
            else if (it < C1) { const int q = it - C0, j = q / I1; r = q - j * I1; K = 384; N = 768; Np = 768; src = P.in[6] + (size_t)j * 384 * 768; dst = (bf16_t*)(ws + W_UQ) + (size_t)j * 768 * 384; }
            else if (it < C2) { const int q = it - C1, j = q / I2; r = q - j * I2; K = 256; N = 1024; Np = 1024; src = P.in[8] + (size_t)j * 256 * 1024; dst = (bf16_t*)(ws + W_UKV) + (size_t)j * 1024 * 256; }
            else if (it < C3) { const int q = it - C2, j = q / I3; r = q - j * I3; K = 1024; N = 1024; Np = 1024; src = P.in[14] + (size_t)j * 1024 * 1024; dst = (bf16_t*)(ws + W_OUTATTN) + (size_t)j * 1024 * 1024; }
            else if (it < C4) { const int q = it - C3, j = q / I4; r = q - j * I4; K = 1024; N = 3072; Np = 3072; src = P.in[15] + (size_t)j * 1024 * 3072; dst = (bf16_t*)(ws + W_INCONV) + (size_t)j * 3072 * 1024; }
            else if (it < C5) { const int q = it - C4, j = q / I5; r = q - j * I5; K = 1024; N = 1024; Np = 1024; src = P.in[17] + (size_t)j * 1024 * 1024; dst = (bf16_t*)(ws + W_OUTCONV) + (size_t)j * 1024 * 1024; }
            else if (it < C6) { const int q = it - C5, j = q / I6; r = q - j * I6; K = 1024; N = 4096; Np = 4096; src = P.in[18] + (size_t)j * 1024 * 4096; dst = (bf16_t*)(ws + W_UP) + (size_t)j * 4096 * 1024; }
            else { const int q = it - C6, j = q / I7; r = q - j * I7; K = 4096; N = 1024; Np = 1024; src = P.in[19] + (size_t)j * 4096 * 1024; dst = (bf16_t*)(ws + W_DOWN) + (size_t)j * 1024 * 4096; }
            transpose_item(src, K, N, Np, dst, scr, r, lane);
        }
        for (int row = gw; row < RT; row += NGW) {
            const int b = row / LP, p = row - b * LP;
            f32x4 v[4];
            if (p < PADF) { v[0] = v[1] = v[2] = v[3] = (f32x4){0.f, 0.f, 0.f, 0.f}; }
            else { const float* srow = (p < 128) ? P.in[1] + (size_t)(p - PADF) * 1024 : P.in[0] + ((size_t)b * 8192 + (p - 128)) * 1024;
#pragma unroll
                for (int j = 0; j < 4; ++j) v[j] = __builtin_nontemporal_load((const f32x4*)srow + lane + 64 * j); }
#pragma unroll
            for (int j = 0; j < 4; ++j) *((f32x4*)(H + (size_t)row * 1024) + lane + 64 * j) = v[j];
            norm_store(v, P.in[2], HN + (size_t)row * 1024, lane);
        }
    }
    xcd_barrier(xbar);

    for (int layer = 0; layer < 4; ++layer) {
        const int jl = layer >> 1;
        const bool even = (layer & 1) == 0;
        const int nsteps = even ? 11 : 7;
        for (int step = 0; step < nsteps; ++step) {
            int kind, sync = 1;
            pg8::Gemm g{nullptr, nullptr, RT, 0, 0, 0}; bf16_t* gout = nullptr; int gld = 0, gact = 0, gfin = 0; const float* ng = nullptr;
            if (even) {
                switch (step) {
                    case 0: kind = 1; g.A = HN; g.Bt = (bf16_t*)(ws + W_INATTN) + (size_t)jl * 2304 * 1024; g.N = 2304; g.K = 1024; gout = Z; gld = ZW; break;
                    case 1: kind = 3; break;
                    case 2: kind = 1; g.A = CQN; g.Bt = (bf16_t*)(ws + W_UQ) + (size_t)jl * 768 * 384; g.N = 768; g.K = 384; gout = QRAW; gld = 768; sync = 0; break;
                    case 3: kind = 1; g.A = CKVN; g.Bt = (bf16_t*)(ws + W_UKV) + (size_t)jl * 1024 * 256; g.N = 1024; g.K = 256; gout = KVRAW; gld = 1024; break;
                    case 4: kind = 4; break;
                    case 5: kind = 5; break;
                    case 6: kind = 2; g.A = OB; g.Bt = (bf16_t*)(ws + W_OUTATTN) + (size_t)jl * 1024 * 1024; g.N = 1024; g.K = 1024; break;
                    case 7: kind = 7; ng = P.in[3] + layer * 1024; break;
                    case 8: kind = 1; g.A = HN; g.Bt = (bf16_t*)(ws + W_UP) + (size_t)layer * 4096 * 1024; g.N = 4096; g.K = 1024; gout = HID; gld = FF; gact = 1; break;
                    case 9: kind = 2; g.A = HID; g.Bt = (bf16_t*)(ws + W_DOWN) + (size_t)layer * 1024 * 4096; g.N = 1024; g.K = 4096; break;
                    default: kind = 7; ng = P.in[2] + (layer + 1) * 1024; break;
                }
            } else {
                switch (step) {
                    case 0: kind = 1; g.A = HN; g.Bt = (bf16_t*)(ws + W_INCONV) + (size_t)jl * 3072 * 1024; g.N = 3072; g.K = 1024; gout = ZC; gld = ZCW; break;
                    case 1: kind = 6; break;
                    case 2: kind = 2; g.A = YB; g.Bt = (bf16_t*)(ws + W_OUTCONV) + (size_t)jl * 1024 * 1024; g.N = 1024; g.K = 1024; break;
                    case 3: kind = 7; ng = P.in[3] + layer * 1024; break;
                    case 4: kind = 1; g.A = HN; g.Bt = (bf16_t*)(ws + W_UP) + (size_t)layer * 4096 * 1024; g.N = 4096; g.K = 1024; gout = HID; gld = FF; gact = 1; break;
                    case 5: kind = 2; g.A = HID; g.Bt = (bf16_t*)(ws + W_DOWN) + (size_t)layer * 1024 * 4096; g.N = 1024; g.K = 4096; gfin = (layer == 3); break;
                    default: kind = 7; ng = P.in[2] + (layer + 1) * 1024; if (layer == 3) kind = 8; break;
                }
            }
            if (kind == 0) continue;
            g.nt = g.K / 64;
            LANE_SETUP();
            if (kind == 1) {
                pg8::StaticOrder S; S.init(RT, g.N, G, bx);
                pg8::EpiBf16 E{gout, gld, gact};
                pg8::gemm_phase<pg8::EpiBf16, pg8::StaticOrder, true, true>((PG8_LAS unsigned char*)lds, g, S, E);
            } else if (kind == 2) {
                pg8::StaticOrder S; S.init(32768, 1024, G, bx);
                pg8::EpiRes E{H, H, P.out, gfin};
                pg8::gemm_phase<pg8::EpiRes, pg8::StaticOrder, true, true>((PG8_LAS unsigned char*)lds, g, S, E);
                pg8::Gemm g2{g.A + (size_t)32768 * g.K, g.Bt, 512, 1024, g.K, g.K / 512};
                pg8::SplitOrder S2{8, G, bx, g.K / 4};
                pg8::EpiPart E2{(float*)(ws + WS_KR), g.K / 4};
                pg8::gemm_phase<pg8::EpiPart, pg8::SplitOrder, true, true>((PG8_LAS unsigned char*)lds, g2, S2, E2);
            } else if (kind == 7) {
                for (int row = gw; row < RT; row += NGW) {
                    f32x4 v[4];
#pragma unroll
                    for (int j = 0; j < 4; ++j) v[j] = __builtin_nontemporal_load((const f32x4*)(H + (size_t)row * 1024) + lane + 64 * j);
                    if (row >= 32768) { const float* pr = (const float*)(ws + WS_KR) + (size_t)(row - 32768) * 1024;
                        for (int s = 0; s < 8; ++s)
#pragma unroll
                            for (int j = 0; j < 4; ++j) v[j] += *((const f32x4*)(pr + (size_t)s * 512 * 1024) + lane + 64 * j);
#pragma unroll
                        for (int j = 0; j < 4; ++j) *((f32x4*)(H + (size_t)row * 1024) + lane + 64 * j) = v[j]; }
                    norm_store(v, ng, HN + (size_t)row * 1024, lane);
                }
            } else if (kind == 8) {
                for (int row = 32768 + gw; row < RT; row += NGW) {
                    f32x4 v[4]; const float* pr = (const float*)(ws + WS_KR) + (size_t)(row - 32768) * 1024;
#pragma unroll
                    for (int j = 0; j < 4; ++j) v[j] = *((const f32x4*)(H + (size_t)row * 1024) + lane + 64 * j);
                    for (int s = 0; s < 8; ++s)
#pragma unroll
                        for (int j = 0; j < 4; ++j) v[j] += *((const f32x4*)(pr + (size_t)s * 512 * 1024) + lane + 64 * j);
                    const size_t orow = (size_t)3 * 8192 + (row - 3 * LP - 128);
#pragma unroll
                    for (int j = 0; j < 4; ++j) *((f32x4*)(P.out + orow * 1024) + lane + 64 * j) = v[j];
                }
            } else if (kind == 3) {
                const float* gcq = P.in[5] + jl * 384; const float* gckv = P.in[7] + jl * 256; const float* gqf = P.in[11] + jl * 64; const float* gkf = P.in[12] + jl * 64; const float* bfg = P.in[13] + jl * 8;
                for (int row = gw; row < RT; row += NGW) {
                    const int p = row % LP; bf16_t* zrow = Z + (size_t)row * ZW; float f[8];
                    { u32x4 w = {0, 0, 0, 0}; if (lane < 48) w = __builtin_nontemporal_load((const u32x4*)(zrow + 8 * lane)); unpack8(w, f);
                      float s = 0.f;
#pragma unroll
                      for (int i = 0; i < 8; ++i) s += f[i] * f[i];
                      const float rstd = __builtin_amdgcn_rsqf(wave_sum(s) * (1.f / 384.f) + EPSN);
                      if (lane < 48) {
#pragma unroll
                          for (int i = 0; i < 8; ++i) f[i] = f[i] * rstd * gcq[8 * lane + i];
                          *(u32x4*)(CQN + (size_t)row * 384 + 8 * lane) = pack8(f); } }
                    { u32x4 w = {0, 0, 0, 0}; if (lane < 32) w = __builtin_nontemporal_load((const u32x4*)(zrow + 384 + 8 * lane)); unpack8(w, f);
                      float s = 0.f;
#pragma unroll
                      for (int i = 0; i < 8; ++i) s += f[i] * f[i];
                      const float rstd = __builtin_amdgcn_rsqf(wave_sum(s) * (1.f / 256.f) + EPSN);
                      if (lane < 32) {
#pragma unroll
                          for (int i = 0; i < 8; ++i) f[i] = f[i] * rstd * gckv[8 * lane + i];
                          *(u32x4*)(CKVN + (size_t)row * 256 + 8 * lane) = pack8(f); } }
#pragma unroll
                    for (int t = 0; t < 2; ++t) { bf16_t* ptr = zrow + 672 + 512 * t + 8 * lane; const u32x4 w = *(const u32x4*)ptr; unpack8(w, f);
                      float s = 0.f;
#pragma unroll
                      for (int i = 0; i < 8; ++i) s += f[i] * f[i];
                      const float rstd = __builtin_amdgcn_rsqf(grp8_sum(s) * (1.f / 64.f) + EPSN) * (t == 0 ? QS_FOX : 1.f);
                      const float* gg = (t == 0 ? gqf : gkf) + 8 * (lane & 7);
#pragma unroll
                      for (int i = 0; i < 8; ++i) f[i] = f[i] * rstd * gg[i];
                      *(u32x4*)ptr = pack8(f); }
                    if (lane < 8) { const float x = __uint_as_float((unsigned)zrow[2208 + lane] << 16) + bfg[lane]; LOGF[(size_t)row * 8 + lane] = (p < PADF) ? 0.f : log_sigmoid(x); }
                }
            } else if (kind == 4) {
                for (int s = bx; s < 32; s += G) {
                    const int b = s >> 3, h = s & 7; const float* src = LOGF + (size_t)b * LP * 8 + h; float* dst = CUM + (size_t)s * LP;
                    const int r0 = tid * 17, r1 = (r0 + 17 < LP) ? r0 + 17 : LP;
                    float loc = 0.f;
                    for (int r = r0; r < r1; ++r) loc += src[(size_t)r * 8];
                    float inc = loc;
#pragma unroll
                    for (int o = 1; o < 64; o <<= 1) { const float t = __shfl_up(inc, o); if (lane >= o) inc += t; }
                    float* wt = (float*)lds;
                    __syncthreads();
                    if (lane == 63) wt[wave] = inc;
                    __syncthreads();
                    float base = 0.f;
                    for (int w = 0; w < wave; ++w) base += wt[w];
                    float run = base + inc - loc;
                    for (int r = r0; r < r1; ++r) { run += src[(size_t)r * 8]; dst[r] = run * LOG2E; }
                    __syncthreads();
                }
                const float* gq = P.in[9] + jl * 96; const float* gk = P.in[10] + jl * 96;
                const int head = lane >> 3, sub = lane & 7;
                for (int row = gw; row < RT; row += NGW) {
                    const int p = row % LP; const int pos = p >= PADF ? p - PADF : 0;
                    float cs[8], sn[8];
#pragma unroll
                    for (int i = 0; i < 8; ++i) { double rv = (double)pos * invf_rev(8 * (sub & 1) + i); rv -= __builtin_floor(rv); const float rf = (float)rv; cs[i] = __builtin_amdgcn_cosf(rf); sn[i] = __builtin_amdgcn_sinf(rf); }
#pragma unroll
                    for (int t = 0; t < 2; ++t) {
                        bf16_t* nrow = t == 0 ? QRAW + (size_t)row * 768 + head * 96 : KVRAW + (size_t)row * 1024 + head * 128;
                        const bf16_t* rsrc = t == 0 ? nrow + 64 : Z + (size_t)row * ZW + 640;
                        const float* gg = t == 0 ? gq : gk;
                        float a[8], rr[8];
                        { const u32x4 w = __builtin_nontemporal_load((const u32x4*)(nrow + 8 * sub)); unpack8(w, a); }
                        { u32x4 w = {0, 0, 0, 0}; if (sub < 4) w = __builtin_nontemporal_load((const u32x4*)(rsrc + 8 * sub)); unpack8(w, rr); }
                        float s = 0.f;
#pragma unroll
                        for (int i = 0; i < 8; ++i) s += a[i] * a[i] + rr[i] * rr[i];
                        const float rstd = __builtin_amdgcn_rsqf(grp8_sum(s) * (1.f / 96.f) + EPSN);
                        const float sc = t == 0 ? QS_MLA : 1.f;
                        float outr[8];
#pragma unroll
                        for (int i = 0; i < 8; ++i) { a[i] = a[i] * rstd * gg[8 * sub + i] * sc; rr[i] = rr[i] * rstd * gg[64 + 8 * (sub & 3) + i] * sc; }
#pragma unroll
                        for (int i = 0; i < 8; ++i) { const float other = __shfl_xor(rr[i], 2); outr[i] = (sub & 2) ? rr[i] * cs[i] + other * sn[i] : rr[i] * cs[i] - other * sn[i]; }
                        *(u32x4*)(nrow + 8 * sub) = pack8(a);
                        if (sub < 4) { bf16_t* rd = t == 0 ? nrow + 64 + 8 * sub : KR + (size_t)row * 256 + head * 32 + 8 * sub; *(u32x4*)rd = pack8(outr); }
                    }
                }
            } else if (kind == 5) {
                float fbound;
                { float a = fabsf(P.in[11][jl * 64 + lane]), c = fabsf(P.in[12][jl * 64 + lane]);
#pragma unroll
                  for (int o = 1; o < 64; o <<= 1) { a = fmaxf(a, __shfl_xor(a, o)); c = fmaxf(c, __shfl_xor(c, o)); }
                  fbound = 64.f * a * c * QS_FOX * 1.02f; }
                const int vcu = (G % 8 == 0) ? (bx % 8) * (G / 8) + bx / 8 : bx;
                for (int item = vcu; item < 1088; item += G) {
                    const int seq = item < 1024 ? item >> 4 : item - 1024; const int pr = item & 15;
                    const int fox = seq >> 5, b = (seq >> 3) & 3, h = seq & 7; const size_t rb = (size_t)b * LP;
                    for (int u = 0; u < 2; ++u) {
                        int qblk; if (item >= 1024) { if (u) break; qblk = -1; } else qblk = u ? 31 - pr : pr;
                        if (fox) att::attn_unit<true>(Z + rb * ZW + 672 + 64 * h, ZW, Z + rb * ZW + 1184 + 64 * h, ZW, nullptr, Z + rb * ZW + 1696 + 64 * h, ZW, OB + rb * 1024 + 512 + 64 * h, CUM + (size_t)(b * 8 + h) * LP, fbound, qblk, (char*)lds);
                        else att::attn_unit<false>(QRAW + rb * 768 + 96 * h, 768, KVRAW + rb * 1024 + 128 * h, 1024, KR + rb * 256 + 32 * h, KVRAW + rb * 1024 + 128 * h + 64, 1024, OB + rb * 1024 + 64 * h, nullptr, 0.f, qblk, (char*)lds);
                    }
                }
            } else if (kind == 6) {
                const float* cw = P.in[16] + (size_t)jl * 3 * 1024;
                for (int item = gw; item < (RT / 16) * 2; item += NGW) {
                    const int rblk = item >> 1, col = (item & 1) * 512 + 8 * lane; const int r0 = rblk * 16; const int p0 = r0 % LP;
                    if (p0 < PADF) { for (int t = 0; t < 16; ++t) *(u32x4*)(YB + (size_t)(r0 + t) * 1024 + col) = (u32x4){0, 0, 0, 0}; continue; }
                    float w0[8], w1[8], w2[8], g2[8], g1[8], c[8], uu[8], bb[8];
#pragma unroll
                    for (int i = 0; i < 8; ++i) { w0[i] = cw[col + i]; w1[i] = cw[1024 + col + i]; w2[i] = cw[2048 + col + i]; }
                    { const bf16_t* zr = ZC + (size_t)(r0 - 2) * ZCW + col; unpack8(*(const u32x4*)(zr + 1024), c); unpack8(*(const u32x4*)(zr + 2048), uu);
#pragma unroll
                      for (int i = 0; i < 8; ++i) g2[i] = c[i] * uu[i]; }
                    { const bf16_t* zr = ZC + (size_t)(r0 - 1) * ZCW + col; unpack8(*(const u32x4*)(zr + 1024), c); unpack8(*(const u32x4*)(zr + 2048), uu);
#pragma unroll
                      for (int i = 0; i < 8; ++i) g1[i] = c[i] * uu[i]; }
                    for (int t = 0; t < 16; ++t) { const bf16_t* zr = ZC + (size_t)(r0 + t) * ZCW + col;
                        unpack8(__builtin_nontemporal_load((const u32x4*)zr), bb); unpack8(__builtin_nontemporal_load((const u32x4*)(zr + 1024)), c); unpack8(__builtin_nontemporal_load((const u32x4*)(zr + 2048)), uu);
                        float y[8];
#pragma unroll
                        for (int i = 0; i < 8; ++i) { const float g0 = c[i] * uu[i]; y[i] = bb[i] * (w0[i] * g2[i] + w1[i] * g1[i] + w2[i] * g0); g2[i] = g1[i]; g1[i] = g0; }
                        *(u32x4*)(YB + (size_t)(r0 + t) * 1024 + col) = pack8(y); }
                }
            }
            if (sync) xcd_barrier(xbar); else __syncthreads();
        }
    }
}

extern "C" void kernel_launch(void* const* d_in, const int* in_sizes, int n_in, void* d_out, int out_size, void* d_ws, size_t ws_size, hipStream_t stream) {
    static int grid_blocks = 0;
    if (!grid_blocks) {
        int dev = 0, cus = 0, per_cu = 0;
        hipGetDevice(&dev);
        hipDeviceGetAttribute(&cus, hipDeviceAttributeMultiprocessorCount, dev);
        hipFuncSetAttribute((const void*)fwd_megakernel, hipFuncAttributeMaxDynamicSharedMemorySize, LDS_BYTES);
        hipOccupancyMaxActiveBlocksPerMultiprocessor(&per_cu, (const void*)fwd_megakernel, NTHR, LDS_BYTES);
        if (per_cu < 1) per_cu = 1;
        grid_blocks = cus * per_cu;
        if (ws_size < WS_END) fprintf(stderr, "kernel_launch: workspace too small: %zu < %zu\n", ws_size, (size_t)WS_END);
        if (n_in != 20) fprintf(stderr, "kernel_launch: expected 20 inputs, got %d\n", n_in);
    }
    Params p{};
    for (int i = 0; i < 20; ++i) p.in[i] = (const float*)d_in[i];
    p.out = (float*)d_out; p.ws = (unsigned char*)d_ws;
    void* args[] = {&p};
    hipError_t e = hipLaunchCooperativeKernel((const void*)fwd_megakernel, dim3(grid_blocks), dim3(NTHR), args, LDS_BYTES, stream);
    if (e != hipSuccess) fprintf(stderr, "cooperative launch failed: %s (grid %d)\n", hipGetErrorString(e), grid_blocks);
}
```

```cpp
#include <hip/hip_runtime.h>
#include <hip/hip_cooperative_groups.h>
#include <cstdio>
#include <cstdint>
namespace cg = cooperative_groups;
__device__ __forceinline__ int opaque_tid() { int t = threadIdx.x; asm volatile("" : "+v"(t)); return t; }

namespace pg8 {
#define PG8_LAS __attribute__((address_space(3)))
typedef unsigned short bf16_t;
typedef short bf16x8 __attribute__((ext_vector_type(8)));
typedef float f32x4 __attribute__((ext_vector_type(4)));
typedef unsigned u32x4 __attribute__((ext_vector_type(4)));
constexpr int BM = 256, BK = 64, HALF = 128, HTB = HALF * BK * 2  , STAGE_BYTES = 8 * HTB, NXCD = 8, WGM = 8;

__host__ __device__ __forceinline__ int lds_byte(int r, int c) { const int st = (r >> 4) * 2 + (c >> 5), rr = r & 15, cc = c & 31, ob = rr * 64 + cc * 2; return st * 1024 + (ob ^ (((ob >> 9) & 1) << 5)); }
__host__ __device__ __forceinline__ void stage_rc(int b, int& R, int& C) { const int st = b / 1024, sb = b % 1024, swz = sb ^ (((sb >> 9) & 1) << 5); R = (st >> 1) * 16 + swz / 64; C = (st & 1) * 32 + (swz % 64) / 2; }
__host__ __device__ __forceinline__ int perm32(int rho) { const int n = rho >> 4, i = rho & 15; return 8 * (i >> 2) + 4 * n + (i & 3); }

struct Unit { int pm, pn, ko; };
struct Gemm { const bf16_t* A; const bf16_t* Bt; int M, N, K, nt; };

struct StaticOrder {
    int nM, nN, nwg, G, c;
    __host__ __device__ void init(int M, int N, int G_, int c_) { nM = M / BM; nN = N / BM; nwg = nM * nN; G = G_; c = c_; }
    __host__ __device__ bool next(int i, Unit& u) const {
        const long L = (long)i * G + c; if (L >= nwg) return false;
        int wgid = (int)L; { const int q = nwg / NXCD, r = nwg % NXCD, xcd = wgid % NXCD, off = wgid / NXCD; wgid = (xcd < r ? xcd * (q + 1) : r * (q + 1) + (xcd - r) * q) + off; }
        const int nig = WGM * nN, gid = wgid / nig, fm = gid * WGM, gsz = (nM - fm) < WGM ? (nM - fm) : WGM;
        u.pm = fm + ((wgid % nig) % gsz); u.pn = (wgid % nig) / gsz; u.ko = 0; return true;
    }
    __device__ __forceinline__ void a_ready(const Unit&) const {}
    __device__ __forceinline__ void done(const Unit&) const {}
};

__device__ __forceinline__ unsigned cvt_pk_bf16(float lo, float hi) { unsigned r; asm volatile("v_cvt_pk_bf16_f32 %0, %1, %2" : "=v"(r) : "v"(lo), "v"(hi)); return r; }
typedef float f32x2 __attribute__((ext_vector_type(2)));
typedef __bf16 bf16x2_t __attribute__((ext_vector_type(2)));
__device__ __forceinline__ unsigned pk2(float lo, float hi) { f32x2 v = {lo, hi}; bf16x2_t b = __builtin_convertvector(v, bf16x2_t); return __builtin_bit_cast(unsigned, b); }
struct EpiBf16 {
    static constexpr bool PERM = true, AFTER_DRAIN = false;
    bf16_t* O; int ldc; int act;
    __device__ __forceinline__ void operator()(const f32x4 (&acc)[2][2][4][2], const Unit& u, int wr, int wc, int fr, int fq) const {
        const int row0 = u.pm * BM + wr * 64 + fr; const int col0 = u.pn * BM + wc * 32 + 8 * fq;
#pragma unroll
        for (int ai = 0; ai < 2; ++ai)
#pragma unroll
            for (int m = 0; m < 4; ++m) { bf16_t* rowp = O + (size_t)(row0 + ai * HALF + m * 16) * ldc + col0;
#pragma unroll
                for (int bj = 0; bj < 2; ++bj) { f32x4 v0 = acc[ai][bj][m][0], v1 = acc[ai][bj][m][1];
                    if (act) { const f32x4 z = {0.f, 0.f, 0.f, 0.f}; v0 = __builtin_elementwise_max(v0, z); v1 = __builtin_elementwise_max(v1, z); v0 = v0 * v0; v1 = v1 * v1; }
                    u32x4 w; w.x = pk2(v0[0], v0[1]); w.y = pk2(v0[2], v0[3]); w.z = pk2(v1[0], v1[1]); w.w = pk2(v1[2], v1[3]);
                    *(u32x4*)(rowp + bj * HALF) = w; } }
    }
};
struct EpiRes {
    static constexpr bool PERM = true, AFTER_DRAIN = false;
    const float* base; float* hout; float* dout; int fin;
    __device__ __forceinline__ void operator()(const f32x4 (&acc)[2][2][4][2], const Unit& u, int wr, int wc, int fr, int fq) const {
        const int row0 = u.pm * BM + wr * 64 + fr; const int col0 = u.pn * BM + wc * 32 + 8 * fq;
#pragma unroll
        for (int ai = 0; ai < 2; ++ai)
#pragma unroll
            for (int m = 0; m < 4; ++m) { const int row = row0 + ai * HALF + m * 16; const size_t off = (size_t)row * 1024 + col0;
                const int bb = row / 8320, pp = row - bb * 8320; const size_t ooff = ((size_t)bb * 8192 + (pp - 128)) * 1024 + col0;
#pragma unroll
                for (int bj = 0; bj < 2; ++bj) {
                    const f32x4 r0 = *(const f32x4*)(base + off + bj * HALF) + acc[ai][bj][m][0];
                    const f32x4 r1 = *(const f32x4*)(base + off + bj * HALF + 4) + acc[ai][bj][m][1];
                    if (!fin) { *(f32x4*)(hout + off + bj * HALF) = r0; *(f32x4*)(hout + off + bj * HALF + 4) = r1; }
                    else if (pp >= 128) { __builtin_nontemporal_store(r0, (f32x4*)(dout + ooff + bj * HALF)); __builtin_nontemporal_store(r1, (f32x4*)(dout + ooff + bj * HALF + 4)); } } }
    }
};

struct SplitOrder {
    int S, G, c, kb;
    __host__ __device__ bool next(int i, Unit& u) const { const int L = i * G + c; if (L >= 8 * S) return false; const int ks = L % S, t = L / S; u.pm = t >> 2; u.pn = t & 3; u.ko = ks * kb; return true; }
    __device__ __forceinline__ void a_ready(const Unit&) const {}
    __device__ __forceinline__ void done(const Unit&) const {}
};
struct EpiPart {
    static constexpr bool PERM = true, AFTER_DRAIN = false;
    float* part; int kb;
    __device__ __forceinline__ void operator()(const f32x4 (&acc)[2][2][4][2], const Unit& u, int wr, int wc, int fr, int fq) const {
        const int row0 = u.pm * BM + wr * 64 + fr; const int col0 = u.pn * BM + wc * 32 + 8 * fq; const int ks = u.ko / kb;
#pragma unroll
        for (int ai = 0; ai < 2; ++ai)
#pragma unroll
            for (int m = 0; m < 4; ++m) { float* dst = part + ((size_t)ks * 512 + (row0 + ai * HALF + m * 16)) * 1024 + col0;
#pragma unroll
                for (int bj = 0; bj < 2; ++bj) { *(f32x4*)(dst + bj * HALF) = acc[ai][bj][m][0]; *(f32x4*)(dst + bj * HALF + 4) = acc[ai][bj][m][1]; } }
    }
};
template <class Epi, class Sched, bool ALIGN_EPI = false, bool SP2 = false>
__device__ __forceinline__ void gemm_phase(PG8_LAS unsigned char* lds, const Gemm g, const Sched& S, const Epi& E) {
    const int tid = opaque_tid(), wid = __builtin_amdgcn_readfirstlane(tid >> 6), lane = tid & 63, wr = wid >> 2, wc = wid & 3, fr = lane & 15, fq = lane >> 4;
    const int K = g.K, nt = g.nt;
    unsigned voffA[2], voffB[2];
#pragma unroll
    for (int i = 0; i < 2; ++i) { int R, C; stage_rc(tid * 16 + i * 8192, R, C); const int Rb = Epi::PERM ? ((R & ~31) + perm32(R & 31)) : R;
        voffA[i] = (unsigned)(R * K + C) * 2u; voffB[i] = (unsigned)(Rb * K + C) * 2u; }
    const size_t kstep = (size_t)(BK * 2);
    const size_t hstep = (size_t)HALF * K * 2;
    const size_t tstep = 2 * hstep;
    const unsigned ldsw = (unsigned)wid * 1024u;
    const int aoff = lds_byte(wr * 64 + fr, fq * 8), boff = lds_byte(wc * 32 + fr, fq * 8);
#define PG8_SA(b, h) (((b) * 2 + (h)) * HTB)
#define PG8_SB(b, h) ((4 + (b) * 2 + (h)) * HTB)
#define PG8_STAGE(bufoff, gbase, voff) do { _Pragma("unroll") for (int _i = 0; _i < 2; ++_i) \
        __builtin_amdgcn_global_load_lds((const unsigned*)((const char*)(gbase) + (voff)[_i]), (PG8_LAS unsigned*)(lds + (bufoff) + ldsw + _i * 8192), 16, 0, 0); } while (0)
#define PG8_LDA(dst, b, h) do { _Pragma("unroll") for (int m = 0; m < 4; ++m) _Pragma("unroll") for (int k = 0; k < 2; ++k) dst[m][k] = *(const PG8_LAS bf16x8*)(lds + PG8_SA(b, h) + aoff + m * 2048 + k * 1024); } while (0)
#define PG8_LDB(dst, b, h) do { _Pragma("unroll") for (int n = 0; n < 2; ++n) _Pragma("unroll") for (int k = 0; k < 2; ++k) dst[n][k] = *(const PG8_LAS bf16x8*)(lds + PG8_SB(b, h) + boff + n * 2048 + k * 1024); } while (0)
#define PG8_MMA(ai, bj, At, Bt) do { __builtin_amdgcn_s_setprio(1); _Pragma("unroll") for (int m = 0; m < 4; ++m) _Pragma("unroll") for (int n = 0; n < 2; ++n) _Pragma("unroll") for (int k = 0; k < 2; ++k) \
        acc[ai][bj][m][n] = __builtin_amdgcn_mfma_f32_16x16x32_bf16(Bt[n][k], At[m][k], acc[ai][bj][m][n], 0, 0, 0); __builtin_amdgcn_s_setprio(0); } while (0)
#define PG8_WAIT_V(n) asm volatile("s_waitcnt vmcnt(" #n ")" ::: "memory")
#define PG8_WAIT_L(n) asm volatile("s_waitcnt lgkmcnt(" #n ")" ::: "memory")
#define PG8_BAR __builtin_amdgcn_s_barrier()
#define PG8_SCHED __builtin_amdgcn_sched_barrier(0)
    Unit cur, nxt; int ui = 0;
    if (!S.next(0, cur)) return;
    f32x4 acc[2][2][4][2];
#pragma unroll
    for (int a = 0; a < 2; ++a)
#pragma unroll
        for (int b = 0; b < 2; ++b)
#pragma unroll
            for (int m = 0; m < 4; ++m)
#pragma unroll
                for (int n = 0; n < 2; ++n) acc[a][b][m][n] = (f32x4){0.f, 0.f, 0.f, 0.f};
    bf16x8 At[4][2], B0[2][2], B1[2][2];
    const char* cA = (const char*)g.A + (size_t)cur.pm * tstep + cur.ko; const char* cB = (const char*)g.Bt + (size_t)cur.pn * tstep + cur.ko;
    S.a_ready(cur);
    if constexpr (SP2) {
        PG8_STAGE(PG8_SB(0, 0), cB, voffB); PG8_STAGE(PG8_SB(0, 1), cB + hstep, voffB); PG8_STAGE(PG8_SA(0, 0), cA, voffA); PG8_STAGE(PG8_SA(0, 1), cA + hstep, voffA);
        if (wr == 1) PG8_BAR;
        PG8_WAIT_V(2); PG8_BAR;
        PG8_STAGE(PG8_SB(1, 0), cB + kstep, voffB); PG8_STAGE(PG8_SA(1, 0), cA + kstep, voffA); PG8_STAGE(PG8_SB(1, 1), cB + hstep + kstep, voffB);
        PG8_WAIT_V(6); PG8_BAR;
    } else {
        PG8_STAGE(PG8_SB(0, 0), cB, voffB); PG8_STAGE(PG8_SA(0, 0), cA, voffA); PG8_STAGE(PG8_SB(0, 1), cB + hstep, voffB); PG8_STAGE(PG8_SA(0, 1), cA + hstep, voffA);
        if (wr == 1) PG8_BAR;
        PG8_WAIT_V(4); PG8_BAR;
        PG8_STAGE(PG8_SB(1, 0), cB + kstep, voffB); PG8_STAGE(PG8_SA(1, 0), cA + kstep, voffA); PG8_STAGE(PG8_SB(1, 1), cB + hstep + kstep, voffB);
        PG8_WAIT_V(6); PG8_BAR;
    }
    for (;;) {
        const bool has_next = S.next(ui + 1, nxt);
        const char* nA = has_next ? (const char*)g.A + (size_t)nxt.pm * tstep + nxt.ko : cA; const char* nB = has_next ? (const char*)g.Bt + (size_t)nxt.pn * tstep + nxt.ko : cB;
        for (int t = 0; t < nt; t += 2) {
            const bool last = (t == nt - 2);
            const char* a1 = cA + (size_t)(t + 1) * kstep;
            const char* a2 = last ? nA : cA + (size_t)(t + 2) * kstep; const char* b2 = last ? nB : cB + (size_t)(t + 2) * kstep;
            const char* a3 = a2 + kstep; const char* b3 = b2 + kstep;
            if (last && has_next) S.a_ready(nxt);
            if constexpr (SP2) {
            PG8_LDB(B0, 0, 0); PG8_LDB(B1, 0, 1); PG8_SCHED; PG8_LDA(At, 0, 0); PG8_STAGE(PG8_SA(1, 1), a1 + hstep, voffA);
            PG8_WAIT_V(8); PG8_WAIT_L(0); PG8_BAR; PG8_MMA(0, 0, At, B0); PG8_MMA(0, 1, At, B1); PG8_BAR; PG8_SCHED;
            PG8_LDA(At, 0, 1); PG8_STAGE(PG8_SB(0, 0), b2, voffB); PG8_STAGE(PG8_SB(0, 1), b2 + hstep, voffB); PG8_STAGE(PG8_SA(0, 0), a2, voffA);
            PG8_WAIT_V(8); PG8_WAIT_L(0); PG8_BAR; PG8_MMA(1, 0, At, B0); PG8_MMA(1, 1, At, B1); PG8_BAR; PG8_SCHED;
            PG8_LDB(B0, 1, 0); PG8_LDB(B1, 1, 1); PG8_SCHED; PG8_LDA(At, 1, 0); PG8_STAGE(PG8_SA(0, 1), a2 + hstep, voffA);
            PG8_WAIT_V(8); PG8_WAIT_L(0); PG8_BAR; PG8_MMA(0, 0, At, B0); PG8_MMA(0, 1, At, B1); PG8_BAR; PG8_SCHED;
            PG8_LDA(At, 1, 1); PG8_STAGE(PG8_SB(1, 0), b3, voffB); PG8_STAGE(PG8_SB(1, 1), b3 + hstep, voffB); PG8_STAGE(PG8_SA(1, 0), a3, voffA);
            PG8_WAIT_V(8); PG8_WAIT_L(0); PG8_BAR; PG8_MMA(1, 0, At, B0); PG8_MMA(1, 1, At, B1); PG8_BAR; PG8_SCHED;
            } else {
            PG8_LDB(B0, 0, 0); PG8_SCHED; PG8_LDA(At, 0, 0); PG8_STAGE(PG8_SA(1, 1), a1 + hstep, voffA);
            PG8_WAIT_L(8); PG8_BAR; PG8_WAIT_L(0); PG8_MMA(0, 0, At, B0); PG8_BAR; PG8_SCHED;
            PG8_LDB(B1, 0, 1); PG8_STAGE(PG8_SB(0, 0), b2, voffB);
            PG8_BAR; PG8_WAIT_L(0); PG8_MMA(0, 1, At, B1); PG8_BAR;
            PG8_LDA(At, 0, 1); PG8_STAGE(PG8_SA(0, 0), a2, voffA);
            PG8_BAR; PG8_WAIT_L(0); PG8_MMA(1, 0, At, B0); PG8_BAR; PG8_SCHED;
            PG8_STAGE(PG8_SB(0, 1), b2 + hstep, voffB);
            PG8_WAIT_V(6); PG8_BAR; PG8_MMA(1, 1, At, B1); PG8_BAR;
            PG8_LDB(B0, 1, 0); PG8_SCHED; PG8_LDA(At, 1, 0); PG8_STAGE(PG8_SA(0, 1), a2 + hstep, voffA);
            PG8_WAIT_L(8); PG8_BAR; PG8_WAIT_L(0); PG8_MMA(0, 0, At, B0); PG8_BAR; PG8_SCHED;
            PG8_LDB(B1, 1, 1); PG8_STAGE(PG8_SB(1, 0), b3, voffB);
            PG8_BAR; PG8_WAIT_L(0); PG8_MMA(0, 1, At, B1); PG8_BAR;
            PG8_LDA(At, 1, 1); PG8_STAGE(PG8_SA(1, 0), a3, voffA);
            PG8_BAR; PG8_WAIT_L(0); PG8_MMA(1, 0, At, B0); PG8_BAR; PG8_SCHED;
            PG8_STAGE(PG8_SB(1, 1), b3 + hstep, voffB);
            PG8_WAIT_V(6); PG8_BAR; PG8_MMA(1, 1, At, B1); PG8_BAR;
            }
        }
        if constexpr (ALIGN_EPI) { if (wr == 0) PG8_BAR; }
        if constexpr (!Epi::AFTER_DRAIN) { E(acc, cur, wr, wc, fr, fq); S.done(cur); }
        if (!has_next) break;
#pragma unroll
        for (int a = 0; a < 2; ++a)
#pragma unroll
            for (int b = 0; b < 2; ++b)
#pragma unroll
                for (int m = 0; m < 4; ++m)
#pragma unroll
                    for (int n = 0; n < 2; ++n) acc[a][b][m][n] = (f32x4){0.f, 0.f, 0.f, 0.f};
        cur = nxt; cA = nA; cB = nB; ++ui;
        if constexpr (ALIGN_EPI) { if (wr == 1) PG8_BAR; }
    }
    PG8_WAIT_V(0);
    if constexpr (!ALIGN_EPI) { if (wr == 0) PG8_BAR; }
    PG8_BAR;
    if constexpr (Epi::AFTER_DRAIN) { E.fused(acc, cur, wr, wc, fr, fq, lds, wid, lane); S.done(cur); }
#undef PG8_SA
#undef PG8_SB
#undef PG8_STAGE
#undef PG8_LDA
#undef PG8_LDB
#undef PG8_MMA
#undef PG8_WAIT_V
#undef PG8_WAIT_L
#undef PG8_BAR
#undef PG8_SCHED
}
}
typedef unsigned short bf16_t;
typedef short bf16x8 __attribute__((ext_vector_type(8)));
typedef short s16x4 __attribute__((ext_vector_type(4)));
typedef float f32x4 __attribute__((ext_vector_type(4)));
typedef float f32x16 __attribute__((ext_vector_type(16)));
typedef unsigned u32x4 __attribute__((ext_vector_type(4)));
using pg8::pk2;
constexpr int NB = 4, LP = 8320, PADF = 112, RT = NB * LP;
constexpr int DM = 1024, ZW = 2304, ZCW = 3072, FF = 4096;
constexpr float EPSN = 1e-6f;
constexpr float QS_MLA = 0.14724444602590306f, QS_FOX = 0.18033688011112042f, LOG2E = 1.4426950408889634f;
constexpr size_t W_INATTN = 0, W_UQ = W_INATTN + 2ull * 2304 * 1024 * 2, W_UKV = W_UQ + 2ull * 768 * 384 * 2, W_OUTATTN = W_UKV + 2ull * 1024 * 256 * 2,
    W_INCONV = W_OUTATTN + 2ull * 1024 * 1024 * 2, W_OUTCONV = W_INCONV + 2ull * 3072 * 1024 * 2, W_UP = W_OUTCONV + 2ull * 1024 * 1024 * 2, W_DOWN = W_UP + 4ull * 4096 * 1024 * 2,
    WS_H = W_DOWN + 4ull * 4096 * 1024 * 2, WS_T = WS_H + (size_t)RT * 1024 * 4, WS_KR = WS_T + (size_t)RT * 4096 * 2, WS_END = WS_KR + (size_t)RT * 256 * 2;
constexpr size_t T_Z = 0, T_QRAW = (size_t)RT * ZW * 2, T_KVRAW = T_QRAW + (size_t)RT * 768 * 2, T_YB = (size_t)RT * ZCW * 2;
constexpr size_t O_HN = 0, O_CQN = (size_t)RT * 1024 * 2, O_CKVN = O_CQN + (size_t)RT * 384 * 2, O_LOGF = O_CKVN + (size_t)RT * 256 * 2, O_CUM = O_LOGF + (size_t)RT * 8 * 4, O_END = O_CUM + (size_t)RT * 8 * 4;
constexpr size_t WS_BAR = (WS_END + 255) & ~(size_t)255, WS_BAR_BYTES = 16384;
static_assert(WS_BAR + WS_BAR_BYTES <= 536870912ull && O_END <= 134217728ull, "scratch maps");

__device__ __forceinline__ float bflo(unsigned u) { return __uint_as_float(u << 16); }
__device__ __forceinline__ float bfhi(unsigned u) { return __uint_as_float(u & 0xffff0000u); }
__device__ __forceinline__ void unpack8(const u32x4 w, float (&f)[8]) { f[0] = bflo(w.x); f[1] = bfhi(w.x); f[2] = bflo(w.y); f[3] = bfhi(w.y); f[4] = bflo(w.z); f[5] = bfhi(w.z); f[6] = bflo(w.w); f[7] = bfhi(w.w); }
__device__ __forceinline__ u32x4 pack8(const float (&f)[8]) { u32x4 w; w.x = pk2(f[0], f[1]); w.y = pk2(f[2], f[3]); w.z = pk2(f[4], f[5]); w.w = pk2(f[6], f[7]); return w; }
__device__ __forceinline__ float wave_sum(float v) {
#pragma unroll
    for (int o = 1; o < 64; o <<= 1) v += __shfl_xor(v, o);
    return v;
}
__device__ __forceinline__ float grp8_sum(float v) { v += __shfl_xor(v, 1); v += __shfl_xor(v, 2); v += __shfl_xor(v, 4); return v; }

namespace att {
constexpr int KB_MAX = 12288, VBY = 8192, FBY = 256, BUF = KB_MAX + VBY + FBY;
constexpr int LDS_WS = 2 * BUF, LDS_OST = LDS_WS + 8 * 256, LDS_BYTES = LDS_OST + 8 * 4096;
constexpr float NEG = -1e30f;
__device__ __forceinline__ int crow(int r, int hi) { return (r & 3) + 8 * (r >> 2) + 4 * hi; }
__device__ __forceinline__ float max3f(float a, float b, float c) { float r; asm("v_max3_f32 %0, %1, %2, %3" : "=v"(r) : "v"(a), "v"(b), "v"(c)); return r; }
__device__ __forceinline__ float max2f(float a, float b) { float r; asm("v_max_f32_e32 %0, %1, %2" : "=v"(r) : "v"(a), "v"(b)); return r; }
typedef __attribute__((address_space(3))) const char* lds_cptr;
typedef short v4i16_t __attribute__((ext_vector_type(4)));
__device__ __forceinline__ s16x4 vtr(lds_cptr p) { return __builtin_bit_cast(s16x4, __builtin_amdgcn_ds_read_tr16_b64_v4i16((__attribute__((address_space(3))) v4i16_t*)p)); }
__device__ __forceinline__ void pv(f32x16* o, int vb, bf16x8 pa0, bf16x8 pa1, bf16x8 pa2, bf16x8 pa3) {
#pragma unroll
    for (int d0 = 0; d0 < 2; ++d0) { s16x4 lo[4], hi[4];
#pragma unroll
        for (int ks = 0; ks < 4; ++ks) {
            asm volatile("ds_read_b64_tr_b16 %0,%1 offset:%c2" : "=&v"(lo[ks]) : "v"(vb), "i"(d0 * 4096 + ks * 1024) : "memory");
            asm volatile("ds_read_b64_tr_b16 %0,%1 offset:%c2" : "=&v"(hi[ks]) : "v"(vb), "i"(d0 * 4096 + ks * 1024 + 512) : "memory"); }
        asm volatile("s_waitcnt lgkmcnt(0)" ::: "memory"); __builtin_amdgcn_sched_barrier(0);
#define PK(k) (bf16x8){lo[k][0], lo[k][1], lo[k][2], lo[k][3], hi[k][0], hi[k][1], hi[k][2], hi[k][3]}
        o[d0] = __builtin_amdgcn_mfma_f32_32x32x16_bf16(pa0, PK(0), o[d0], 0, 0, 0);
        o[d0] = __builtin_amdgcn_mfma_f32_32x32x16_bf16(pa1, PK(1), o[d0], 0, 0, 0);
        o[d0] = __builtin_amdgcn_mfma_f32_32x32x16_bf16(pa2, PK(2), o[d0], 0, 0, 0);
        o[d0] = __builtin_amdgcn_mfma_f32_32x32x16_bf16(pa3, PK(3), o[d0], 0, 0, 0);
#undef PK
    }
}
template <bool FOX> __device__ __forceinline__ void attn_unit(const bf16_t* __restrict__ Qp, int qpitch, const bf16_t* __restrict__ Kp, int kpitch, const bf16_t* __restrict__ KRp,
                                                              const bf16_t* __restrict__ Vp, int vpitch, bf16_t* Op, const float* __restrict__ F2, float fbound, int qblk, char* shm) {
    constexpr int DK = FOX ? 64 : 96, ND0 = DK / 16;
    const int tid = opaque_tid(), lane = tid & 63, r32 = lane & 31, hi = lane >> 5; const int wid = __builtin_amdgcn_readfirstlane(tid >> 6);
    const bool tiny = qblk < 0;
    const int q0 = tiny ? 0 : 128 + 256 * qblk;
    const int jend = tiny ? 1 : (q0 + 256) / 64 - 1;
    const int qw0 = q0 + 32 * wid, qrow = qw0 + r32;
    bf16x8 qr[ND0];
#pragma unroll
    for (int d0 = 0; d0 < ND0; ++d0) qr[d0] = *(const bf16x8*)(Qp + (size_t)qrow * qpitch + d0 * 16 + hi * 8);
    float fq2 = 0.f; if (FOX) fq2 = F2[qrow];
    float* wsf = (float*)(shm + LDS_WS) + wid * 64;
    const unsigned lds0 = (unsigned)(uintptr_t)shm;
    const int vlane = ((lane >> 4) & 1) * 32 + (lane & 3) * 8 + (4 * hi + ((lane & 15) >> 2)) * 64;
    u32x4 kreg = {0, 0, 0, 0}, krreg = {0, 0, 0, 0}, vreg = {0, 0, 0, 0}; float freg = 0.f;
#define ATT_LOAD(j) do { const int kv0_ = 64 * (j); \
        kreg = *(const u32x4*)(Kp + (size_t)(kv0_ + lane) * kpitch + wid * 8); \
        if (!FOX && wid < 4) krreg = *(const u32x4*)(KRp + (size_t)(kv0_ + lane) * 256 + wid * 8); \
        vreg = *(const u32x4*)(Vp + (size_t)(kv0_ + 16 * (wid & 3) + (lane >> 2)) * vpitch + (wid >> 2) * 32 + (lane & 3) * 8); \
        if (FOX && wid == 0) freg = F2[kv0_ + lane]; } while (0)
#define ATT_STORE(buf) do { char* b_ = shm + (buf) * BUF; \
        *(u32x4*)(b_ + wid * 1024 + lane * 16) = kreg; \
        if (!FOX && wid < 4) *(u32x4*)(b_ + (8 + wid) * 1024 + lane * 16) = krreg; \
        *(u32x4*)(b_ + KB_MAX + wid * 1024 + lane * 16) = vreg; \
        if (FOX && wid == 0) *(float*)(b_ + KB_MAX + VBY + lane * 4) = freg; } while (0)
    float m_run = 0.f, l_run = 0.f; f32x16 o[2]; o[0] = f32x16{}; o[1] = f32x16{};
    f32x16 negm = f32x16{};
    int jstart = 1;
    if (FOX && !tiny) { const int jj = tid + 1; const bool sk = jj <= jend && (F2[q0] - F2[64 * (jj <= jend ? jj : jend) + 63] + fbound < -175.0f); jstart = 1 + __syncthreads_count(sk ? 1 : 0); if (jstart > jend) jstart = jend; }
    ATT_LOAD(jstart); ATT_STORE(0); __syncthreads();
#define VFR(i) __builtin_shufflevector(vlo[i], vhi[i], 0, 1, 2, 3, 4, 5, 6, 7)
#define ATT_BODY(MASKED, PADM) do { \
        const int buf = (j - jstart) & 1; \
        if (j < jend) ATT_LOAD(j + 1); \
        const int kv0 = 64 * j; \
        if (!(MASKED) || kv0 <= qw0 + 31) { \
            const char* Kb = shm + buf * BUF; \
            const lds_cptr vp = (lds_cptr)shm + buf * BUF + KB_MAX + vlane; \
            s16x4 vlo[8], vhi[8]; \
        _Pragma("unroll") \
            for (int i = 0; i < 8; ++i) { vlo[i] = vtr(vp + (i >> 2) * 4096 + (i & 3) * 1024); vhi[i] = vtr(vp + (i >> 2) * 4096 + (i & 3) * 1024 + 512); } \
            f32x16 p0, p1; \
            if (FOX) { const float* fb = (const float*)(Kb + KB_MAX + VBY); const float fqm = fq2 - m_run; \
        _Pragma("unroll") \
                for (int g = 0; g < 4; ++g) { const f32x4 a = *(const f32x4*)(fb + 8 * g + 4 * hi), b = *(const f32x4*)(fb + 32 + 8 * g + 4 * hi); \
        _Pragma("unroll") \
                    for (int i = 0; i < 4; ++i) { p0[4 * g + i] = fqm - a[i]; p1[4 * g + i] = fqm - b[i]; } } \
            } else { p0 = negm; p1 = negm; } \
            const char* kb = Kb + hi * 1024 + r32 * 16; \
        _Pragma("unroll") \
            for (int d0 = 0; d0 < ND0; ++d0) { const bf16x8 b0 = *(const bf16x8*)(kb + d0 * 2048), b1 = *(const bf16x8*)(kb + d0 * 2048 + 512); \
                p0 = __builtin_amdgcn_mfma_f32_32x32x16_bf16(b0, qr[d0], p0, 0, 0, 0); p1 = __builtin_amdgcn_mfma_f32_32x32x16_bf16(b1, qr[d0], p1, 0, 0, 0); } \
            if (MASKED) { const int dq_ = qrow - kv0 - 4 * hi; \
        _Pragma("unroll") \
                for (int r = 0; r < 16; ++r) { const int c_ = (r & 3) + 8 * (r >> 2); if (c_ > dq_) p0[r] = NEG; if (c_ + 32 > dq_) p1[r] = NEG; } \
                if (PADM) { const int dp_ = PADF - kv0 - 4 * hi; \
        _Pragma("unroll") \
                for (int r = 0; r < 16; ++r) { const int c_ = (r & 3) + 8 * (r >> 2); if (c_ < dp_) p0[r] = NEG; if (c_ + 32 < dp_) p1[r] = NEG; } } \
            } \
            float rm, rm2; { rm = max3f(p0[0], p0[1], p1[0]); rm2 = max3f(p0[2], p0[3], p1[1]); rm = max3f(rm, p1[2], p1[3]); \
              _Pragma("unroll") for (int r = 4; r < 16; r += 4) { rm = max3f(rm, p0[r], p0[r + 1]); rm2 = max3f(rm2, p0[r + 2], p0[r + 3]); rm = max3f(rm, p1[r], p1[r + 1]); rm2 = max3f(rm2, p1[r + 2], p1[r + 3]); } \
              rm = max2f(rm, rm2); } \
            { auto rr = __builtin_amdgcn_permlane32_swap(__float_as_uint(rm), __float_as_uint(rm), false, false); rm = max2f(__uint_as_float(rr[0]), __uint_as_float(rr[1])); } \
            if (__any(rm > 8.0f)) { \
                const float dl = fmaxf(rm, 0.f); const float f = __builtin_amdgcn_exp2f(-dl); m_run += dl; l_run *= f; \
        _Pragma("unroll") \
                for (int r = 0; r < 16; ++r) { p0[r] -= dl; p1[r] -= dl; negm[r] = -m_run; } \
                if (hi == 0) wsf[r32] = f; \
                asm volatile("s_waitcnt lgkmcnt(0)" ::: "memory"); \
        _Pragma("unroll") \
                for (int r = 0; r < 16; ++r) { const float fac = wsf[crow(r, hi)]; o[0][r] *= fac; o[1][r] *= fac; } \
                asm volatile("s_waitcnt lgkmcnt(0)" ::: "memory"); \
            } \
            float sacc = 0.f; \
        _Pragma("unroll") \
            for (int r = 0; r < 16; ++r) { p0[r] = __builtin_amdgcn_exp2f(p0[r]); p1[r] = __builtin_amdgcn_exp2f(p1[r]); sacc += p0[r] + p1[r]; } \
            l_run += sacc; \
            u32x4 pw0, pw1, pw2, pw3; \
            pw0 = (u32x4){pk2(p0[0], p0[1]), pk2(p0[2], p0[3]), pk2(p0[4], p0[5]), pk2(p0[6], p0[7])}; \
            pw1 = (u32x4){pk2(p0[8], p0[9]), pk2(p0[10], p0[11]), pk2(p0[12], p0[13]), pk2(p0[14], p0[15])}; \
            pw2 = (u32x4){pk2(p1[0], p1[1]), pk2(p1[2], p1[3]), pk2(p1[4], p1[5]), pk2(p1[6], p1[7])}; \
            pw3 = (u32x4){pk2(p1[8], p1[9]), pk2(p1[10], p1[11]), pk2(p1[12], p1[13]), pk2(p1[14], p1[15])}; \
            o[0] = __builtin_amdgcn_mfma_f32_32x32x16_bf16(__builtin_bit_cast(bf16x8, pw0), VFR(0), o[0], 0, 0, 0); \
            o[1] = __builtin_amdgcn_mfma_f32_32x32x16_bf16(__builtin_bit_cast(bf16x8, pw0), VFR(4), o[1], 0, 0, 0); \
            o[0] = __builtin_amdgcn_mfma_f32_32x32x16_bf16(__builtin_bit_cast(bf16x8, pw1), VFR(1), o[0], 0, 0, 0); \
            o[1] = __builtin_amdgcn_mfma_f32_32x32x16_bf16(__builtin_bit_cast(bf16x8, pw1), VFR(5), o[1], 0, 0, 0); \
            o[0] = __builtin_amdgcn_mfma_f32_32x32x16_bf16(__builtin_bit_cast(bf16x8, pw2), VFR(2), o[0], 0, 0, 0); \
            o[1] = __builtin_amdgcn_mfma_f32_32x32x16_bf16(__builtin_bit_cast(bf16x8, pw2), VFR(6), o[1], 0, 0, 0); \
            o[0] = __builtin_amdgcn_mfma_f32_32x32x16_bf16(__builtin_bit_cast(bf16x8, pw3), VFR(3), o[0], 0, 0, 0); \
            o[1] = __builtin_amdgcn_mfma_f32_32x32x16_bf16(__builtin_bit_cast(bf16x8, pw3), VFR(7), o[1], 0, 0, 0); \
        } \
        if (j < jend) ATT_STORE(buf ^ 1); \
        __syncthreads(); \
    } while (0)
    const int jdiag = jend - 3;
    int j = jstart;
    if (j == 1) { ATT_BODY(true, true); ++j; }
    for (; j < jdiag; ++j) { ATT_BODY(false, false); }
    for (; j <= jend; ++j) { ATT_BODY(true, false); }
#undef ATT_BODY
#undef VFR
#undef ATT_LOAD
#undef ATT_STORE
    { auto rr = __builtin_amdgcn_permlane32_swap(__float_as_uint(l_run), __float_as_uint(l_run), false, false); l_run = __uint_as_float(rr[0]) + __uint_as_float(rr[1]); }
    if (hi == 0) wsf[32 + r32] = l_run;
    asm volatile("s_waitcnt lgkmcnt(0)" ::: "memory");
    float rli[16];
#pragma unroll
    for (int r = 0; r < 16; ++r) rli[r] = __builtin_amdgcn_rcpf(wsf[32 + crow(r, hi)]);
    bf16_t* stg = (bf16_t*)(shm + LDS_OST) + wid * 2048;
#pragma unroll
    for (int r = 0; r < 16; ++r) { const int orow = crow(r, hi);
#pragma unroll
        for (int d0 = 0; d0 < 2; ++d0) stg[orow * 64 + d0 * 32 + r32] = (bf16_t)(pk2(o[d0][r] * rli[r], 0.f) & 0xffffu); }
    asm volatile("s_waitcnt lgkmcnt(0)" ::: "memory");
#pragma unroll
    for (int i = 0; i < 4; ++i) { const int row = i * 8 + (lane >> 3), ch = lane & 7; u32x4 v = *(const u32x4*)(stg + row * 64 + ch * 8);
        const int grow = qw0 + row;
        if (tiny) { if (grow >= 128) continue; if (grow < PADF) v = (u32x4){0, 0, 0, 0}; }
        *(u32x4*)(Op + (size_t)grow * 1024 + ch * 8) = v; }
    asm volatile("s_waitcnt lgkmcnt(0)" ::: "memory");
}
}
#define LAS __attribute__((address_space(3)))
#define XB_TMO      128
#define XB_XCNT(j)  (256  + 64 * (j))
#define XB_XSUB(j)  (1280 + 64 * (j))
#define XB_XGEN(j)  (2304 + 64 * (j))
#define XB_TOP      3328
#define XB_TOPGEN   3392
#define XCD_BAR_WORDS 3456
#define XB_SPIN_CAP (1u << 18)

__device__ __forceinline__ unsigned xb_ld(unsigned* p)              { return __hip_atomic_load(p, __ATOMIC_RELAXED, __HIP_MEMORY_SCOPE_AGENT); }
__device__ __forceinline__ unsigned xb_add(unsigned* p, unsigned v) { return __hip_atomic_fetch_add(p, v, __ATOMIC_RELAXED, __HIP_MEMORY_SCOPE_AGENT); }
__device__ __forceinline__ unsigned xb_xcc_id() { return (unsigned)__builtin_amdgcn_s_getreg((3 << 11) | 20) & 0xFu; }
#define XB_SPIN(cond, bar) do { unsigned _sp = 0; while (cond) { __builtin_amdgcn_s_sleep(1); \
    if ((++_sp & 255u) == 0u) { if (xb_ld(&(bar)[XB_TMO])) break; if (_sp > XB_SPIN_CAP) { atomicAdd(&(bar)[XB_TMO], 1u); break; } } } } while (0)

struct XcdBarrier {
    unsigned* bar; unsigned x;
    volatile LAS unsigned* st;
};

__device__ __forceinline__ XcdBarrier xcd_barrier_post(unsigned* bar, volatile LAS unsigned* st) {
    XcdBarrier b; b.bar = bar; b.x = xb_xcc_id(); b.st = st;
    if (threadIdx.x == 0) (void)xb_add(&bar[XB_XCNT(b.x)], 1u);
    return b;
}
__device__ __forceinline__ void xcd_barrier_complete(unsigned* bar, unsigned x, unsigned& nloc, unsigned& nx) {
    const unsigned G = gridDim.x * gridDim.y * gridDim.z;
    unsigned sum, cnt, mine, sp = 0u;
    for (;;) {
        sum = 0u; cnt = 0u; mine = 0u;
#pragma unroll
        for (unsigned j = 0; j < 16; ++j) { const unsigned c = xb_ld(&bar[XB_XCNT(j)]); sum += c; cnt += (c > 0u) ? 1u : 0u; mine = (j == x) ? c : mine; }
        if (sum == G) break;
        __builtin_amdgcn_s_sleep(1);
        if ((++sp & 255u) == 0u) { if (xb_ld(&bar[XB_TMO])) break; if (sp > XB_SPIN_CAP) { atomicAdd(&bar[XB_TMO], 1u); break; } }
    }
    nloc = mine > 0u ? mine : 1u; nx = cnt > 0u ? cnt : 1u;
}

__device__ __forceinline__ void xcd_barrier(const XcdBarrier& b) {
    asm volatile("s_waitcnt vmcnt(0)" ::: "memory");
    __syncthreads();
    if (threadIdx.x == 0) {
        unsigned* bar = b.bar;
        __builtin_amdgcn_s_waitcnt(0);
        unsigned nloc = b.st[0], nx = b.st[1];
        if (nloc == 0u) { xcd_barrier_complete(bar, b.x, nloc, nx); b.st[0] = nloc; b.st[1] = nx; }
        const unsigned old = xb_add(&bar[XB_XSUB(b.x)], 1u);
        const unsigned gen = old / nloc;
        if (old + 1u == (gen + 1u) * nloc) {
            __builtin_amdgcn_fence(__ATOMIC_RELEASE, "agent");
            asm volatile("s_waitcnt vmcnt(0)" ::: "memory");
            const unsigned og = xb_add(&bar[XB_TOP], 1u);
            const unsigned tg = og / nx;
            if (og + 1u == (tg + 1u) * nx) xb_add(&bar[XB_TOPGEN], 1u);
            else XB_SPIN(xb_ld(&bar[XB_TOPGEN]) == tg, bar);
            __builtin_amdgcn_fence(__ATOMIC_ACQUIRE, "agent");
            xb_add(&bar[XB_XGEN(b.x)], 1u);
            asm volatile("s_waitcnt vmcnt(0)" ::: "memory");
        } else {
            XB_SPIN(xb_ld(&bar[XB_XGEN(b.x)]) == gen, bar);
            __builtin_amdgcn_fence(__ATOMIC_ACQUIRE, "agent");
            asm volatile("s_waitcnt vmcnt(0)" ::: "memory");
        }
    }
    __syncthreads();
}

struct Params { const float* in[20]; float* out; unsigned char* ws; };
constexpr int NWAVES = 8, NTHR = 512;
constexpr int LDS_BYTES = 135168;

__device__ __forceinline__ void transpose_item(const float* __restrict__ W, int K, int N, int Npad, bf16_t* __restrict__ WT, float* scr, int item, int lane) {
    const int nblk = Npad / 32, kb = item / nblk, nb = item - kb * nblk, k0 = 64 * kb, n0 = 32 * nb;
    const int nn = n0 + (lane & 31); const bool ok = nn < N;
#pragma unroll 8
    for (int i = 0; i < 32; ++i) { const int kk = 2 * i + (lane >> 5); scr[kk * 33 + (lane & 31)] = ok ? __builtin_nontemporal_load(W + (size_t)(k0 + kk) * N + nn) : 0.f; }
    asm volatile("s_waitcnt lgkmcnt(0)" ::: "memory");
    const int c = lane & 7;
#pragma unroll
    for (int j = 0; j < 4; ++j) { const int n = (lane >> 3) + 8 * j; const float* s = scr + (8 * c) * 33 + n;
        u32x4 o; o.x = pk2(s[0 * 33], s[1 * 33]); o.y = pk2(s[2 * 33], s[3 * 33]); o.z = pk2(s[4 * 33], s[5 * 33]); o.w = pk2(s[6 * 33], s[7 * 33]);
        *(u32x4*)(WT + (size_t)(n0 + n) * K + k0 + 8 * c) = o; }
    asm volatile("s_waitcnt lgkmcnt(0)" ::: "memory");
}
__device__ __forceinline__ void norm_store(const f32x4 (&v)[4], const float* __restrict__ g, bf16_t* orow, int lane) {
    float s = 0.f;
#pragma unroll
    for (int j = 0; j < 4; ++j) s += (v[j].x * v[j].x + v[j].y * v[j].y) + (v[j].z * v[j].z + v[j].w * v[j].w);
    const float rstd = __builtin_amdgcn_rsqf(wave_sum(s) * (1.f / 1024.f) + EPSN);
    unsigned long long* o8 = (unsigned long long*)orow + lane;
#pragma unroll
    for (int j = 0; j < 4; ++j) { const f32x4 gg = *((const f32x4*)g + lane + 64 * j);
        o8[64 * j] = (unsigned long long)pk2(v[j].x * rstd * gg.x, v[j].y * rstd * gg.y) | ((unsigned long long)pk2(v[j].z * rstd * gg.z, v[j].w * rstd * gg.w) << 32); }
}
__device__ __forceinline__ float log_sigmoid(float x) { return fminf(x, 0.f) - log1pf(__expf(-fabsf(x))); }

__device__ __forceinline__ double invf_rev(int i) {
    switch (i) { case 0: return 0.15915494309189535; case 1: return 0.08949940160889101; case 2: return 0.050329212104487035; case 3: return 0.0283021958306234;
        case 4: return 0.015915494309189534; case 5: return 0.008949940160889102; case 6: return 0.005032921210448704; case 7: return 0.00283021958306234;
        case 8: return 0.0015915494309189536; case 9: return 0.0008949940160889102; case 10: return 0.0005032921210448703; case 11: return 0.00028302195830623395;
        case 12: return 0.00015915494309189535; case 13: return 8.949940160889102e-05; case 14: return 5.0329212104487035e-05; default: return 2.8302195830623396e-05; }
}

__global__ void __launch_bounds__(NTHR) fwd_megakernel(Params P) {
    extern __shared__ __attribute__((aligned(16))) unsigned char lds[];
    cg::grid_group grid = cg::this_grid();
    volatile LAS unsigned* bst = (volatile LAS unsigned*)((LAS unsigned char*)lds + 134144);
    if (threadIdx.x == 0) { bst[0] = 0u; bst[1] = 0u; }
    if (blockIdx.x == 0) { unsigned* bw = (unsigned*)(P.ws + WS_BAR); for (int i = threadIdx.x; i < (int)(WS_BAR_BYTES / 4); i += NTHR) __hip_atomic_store(bw + i, 0u, __ATOMIC_RELAXED, __HIP_MEMORY_SCOPE_AGENT); }
    grid.sync();
    const XcdBarrier xbar = xcd_barrier_post((unsigned*)(P.ws + WS_BAR), bst);
    const int G = gridDim.x, bx = blockIdx.x, NGW = G * NWAVES;
#define LANE_SETUP() const int tid = opaque_tid(), lane = tid & 63, wave = __builtin_amdgcn_readfirstlane(tid >> 6); const int gw = bx * NWAVES + wave; (void)gw; (void)lane
    unsigned char* ws = P.ws; unsigned char* ob = (unsigned char*)P.out;
    float* H = (float*)(ws + WS_H);
    bf16_t* HN = (bf16_t*)(ob + O_HN); bf16_t* OB = HN;
    bf16_t* CQN = (bf16_t*)(ob + O_CQN); bf16_t* CKVN = (bf16_t*)(ob + O_CKVN);
    float* LOGF = (float*)(ob + O_LOGF); float* CUM = (float*)(ob + O_CUM);
    bf16_t* Z = (bf16_t*)(ws + WS_T + T_Z); bf16_t* QRAW = (bf16_t*)(ws + WS_T + T_QRAW); bf16_t* KVRAW = (bf16_t*)(ws + WS_T + T_KVRAW);
    bf16_t* ZC = (bf16_t*)(ws + WS_T); bf16_t* YB = (bf16_t*)(ws + WS_T + T_YB); bf16_t* HID = (bf16_t*)(ws + WS_T);
    bf16_t* KR = (bf16_t*)(ws + WS_KR);

    {
        LANE_SETUP();
        float* scr = (float*)(lds + wave * 8448);
        constexpr int I0 = 16 * 72, I1 = 6 * 24, I2 = 4 * 32, I3 = 16 * 32, I4 = 16 * 96, I5 = 16 * 32, I6 = 16 * 128, I7 = 64 * 32;
        constexpr int C0 = 2 * I0, C1 = C0 + 2 * I1, C2 = C1 + 2 * I2, C3 = C2 + 2 * I3, C4 = C3 + 2 * I4, C5 = C4 + 2 * I5, C6 = C5 + 4 * I6, C7 = C6 + 4 * I7;
        for (int it = gw; it < C7; it += NGW) {
            const float* src; bf16_t* dst; int K, N, Np, r;
            if (it < C0) { const int j = it / I0; r = it - j * I0; K = 1024; N = 2216; Np = 2304; src = P.in[4] + (size_t)j * 1024 * 2216; dst = (bf16_t*)(ws + W_INATTN) + (size_t)j * 2304 * 1024; }
            else if (it < C1) { const int q = it - C0, j = q / I1; r = q - j * I1; K = 384; N = 768; Np = 768; src = P.in[6] + (size_t)j * 384 * 768; dst = (bf16_t*)(ws + W_UQ) + (size_t)j * 768 * 384; }
            else if (it < C2) { const int q = it - C1, j = q / I2; r = q - j * I2; K = 256; N = 1024; Np = 1024; src = P.in[8] + (size_t)j * 256 * 1024; dst = (bf16_t*)(ws + W_UKV) + (size_t)j * 1024 * 256; }
            else if (it < C3) { const int q = it - C2, j = q / I3; r = q - j * I3; K = 1024; N = 1024; Np = 1024; src = P.in[14] + (size_t)j * 1024 * 1024; dst = (bf16_t*)(ws + W_OUTATTN) + (size_t)j * 1024 * 1024; }
            else if (it < C4) { const int q = it - C3, j = q / I4; r = q - j * I4; K = 1024; N = 3072; Np = 3072; src = P.in[15] + (size_t)j * 1024 * 3072; dst = (bf16_t*)(ws + W_INCONV) + (size_t)j * 3072 * 1024; }
            else if (it < C5) { const int q = it - C4, j = q / I5; r = q - j * I5; K = 1024; N = 1024; Np = 1024; src = P.in[17] + (size_t)j * 1024 * 1024; dst = (bf16_t*)(ws + W_OUTCONV) + (size_t)j * 1024 * 1024; }
            else if (it < C6) { const int q = it - C5, j = q / I6; r = q - j * I6; K = 1024; N = 4096; Np = 4096; src = P.in[18] + (size_t)j * 1024 * 4096; dst = (bf16_t*)(ws + W_UP) + (size_t)j * 4096 * 1024; }
            else { const int q = it - C6, j = q / I7; r = q - j * I7; K = 4096; N = 1024; Np = 1024; src = P.in[19] + (size_t)j * 4096 * 1024; dst = (bf16_t*)(ws + W_DOWN) + (size_t)j * 1024 * 4096; }
            transpose_item(src, K, N, Np, dst, scr, r, lane);
        }
        for (int row = gw; row < RT; row += NGW) {
            const int b = row / LP, p = row - b * LP;
            f32x4 v[4];
            if (p < PADF) { v[0] = v[1] = v[2] = v[3] = (f32x4){0.f, 0.f, 0.f, 0.f}; }
            else { const float* srow = (p < 128) ? P.in[1] + (size_t)(p - PADF) * 1024 : P.in[0] + ((size_t)b * 8192 + (p - 128)) * 1024;
#pragma unroll
                for (int j = 0; j < 4; ++j) v[j] = __builtin_nontemporal_load((const f32x4*)srow + lane + 64 * j); }
#pragma unroll
            for (int j = 0; j < 4; ++j) *((f32x4*)(H + (size_t)row * 1024) + lane + 64 * j) = v[j];
            norm_store(v, P.in[2], HN + (size_t)row * 1024, lane);
        }
    }
    xcd_barrier(xbar);

    for (int layer = 0; layer < 4; ++layer) {
        const int jl = layer >> 1;
        const bool even = (layer & 1) == 0;
        const int nsteps = even ? 11 : 7;
        for (int step = 0; step < nsteps; ++step) {
            int kind, sync = 1;
            pg8::Gemm g{nullptr, nullptr, RT, 0, 0, 0}; bf16_t* gout = nullptr; int gld = 0, gact = 0, gfin = 0; const float* ng = nullptr;
            if (even) {
                switch (step) {
                    case 0: kind = 1; g.A = HN; g.Bt = (bf16_t*)(ws + W_INATTN) + (size_t)jl * 2304 * 1024; g.N = 2304; g.K = 1024; gout = Z; gld = ZW; break;
                    case 1: kind = 3; break;
                    case 2: kind = 1; g.A = CQN; g.Bt = (bf16_t*)(ws + W_UQ) + (size_t)jl * 768 * 384; g.N = 768; g.K = 384; gout = QRAW; gld = 768; sync = 0; break;
                    case 3: kind = 1; g.A = CKVN; g.Bt = (bf16_t*)(ws + W_UKV) + (size_t)jl * 1024 * 256; g.N = 1024; g.K = 256; gout = KVRAW; gld = 1024; break;
                    case 4: kind = 4; break;
                    case 5: kind = 5; break;
                    case 6: kind = 2; g.A = OB; g.Bt = (bf16_t*)(ws + W_OUTATTN) + (size_t)jl * 1024 * 1024; g.N = 1024; g.K = 1024; break;
                    case 7: kind = 7; ng = P.in[3] + layer * 1024; break;
                    case 8: kind = 1; g.A = HN; g.Bt = (bf16_t*)(ws + W_UP) + (size_t)layer * 4096 * 1024; g.N = 4096; g.K = 1024; gout = HID; gld = FF; gact = 1; break;
                    case 9: kind = 2; g.A = HID; g.Bt = (bf16_t*)(ws + W_DOWN) + (size_t)layer * 1024 * 4096; g.N = 1024; g.K = 4096; break;
                    default: kind = 7; ng = P.in[2] + (layer + 1) * 1024; break;
                }
            } else {
                switch (step) {
                    case 0: kind = 1; g.A = HN; g.Bt = (bf16_t*)(ws + W_INCONV) + (size_t)jl * 3072 * 1024; g.N = 3072; g.K = 1024; gout = ZC; gld = ZCW; break;
                    case 1: kind = 6; break;
                    case 2: kind = 2; g.A = YB; g.Bt = (bf16_t*)(ws + W_OUTCONV) + (size_t)jl * 1024 * 1024; g.N = 1024; g.K = 1024; break;
                    case 3: kind = 7; ng = P.in[3] + layer * 1024; break;
                    case 4: kind = 1; g.A = HN; g.Bt = (bf16_t*)(ws + W_UP) + (size_t)layer * 4096 * 1024; g.N = 4096; g.K = 1024; gout = HID; gld = FF; gact = 1; break;
                    case 5: kind = 2; g.A = HID; g.Bt = (bf16_t*)(ws + W_DOWN) + (size_t)layer * 1024 * 4096; g.N = 1024; g.K = 4096; gfin = (layer == 3); break;
                    default: kind = 7; ng = P.in[2] + (layer + 1) * 1024; if (layer == 3) kind = 8; break;
                }
            }
            if (kind == 0) continue;
            g.nt = g.K / 64;
            LANE_SETUP();
            if (kind == 1) {
                pg8::StaticOrder S; S.init(RT, g.N, G, bx);
                pg8::EpiBf16 E{gout, gld, gact};
                pg8::gemm_phase<pg8::EpiBf16, pg8::StaticOrder, true, true>((PG8_LAS unsigned char*)lds, g, S, E);
            } else if (kind == 2) {
                pg8::StaticOrder S; S.init(32768, 1024, G, bx);
                pg8::EpiRes E{H, H, P.out, gfin};
                pg8::gemm_phase<pg8::EpiRes, pg8::StaticOrder, true, true>((PG8_LAS unsigned char*)lds, g, S, E);
                pg8::Gemm g2{g.A + (size_t)32768 * g.K, g.Bt, 512, 1024, g.K, g.K / 512};
                pg8::SplitOrder S2{8, G, bx, g.K / 4};
                pg8::EpiPart E2{(float*)(ws + WS_KR), g.K / 4};
                pg8::gemm_phase<pg8::EpiPart, pg8::SplitOrder, true, true>((PG8_LAS unsigned char*)lds, g2, S2, E2);
            } else if (kind == 7) {
                for (int row = gw; row < RT; row += NGW) {
                    f32x4 v[4];
#pragma unroll
                    for (int j = 0; j < 4; ++j) v[j] = __builtin_nontemporal_load((const f32x4*)(H + (size_t)row * 1024) + lane + 64 * j);
                    if (row >= 32768) { const float* pr = (const float*)(ws + WS_KR) + (size_t)(row - 32768) * 1024;
                        for (int s = 0; s < 8; ++s)
#pragma unroll
                            for (int j = 0; j < 4; ++j) v[j] += *((const f32x4*)(pr + (size_t)s * 512 * 1024) + lane + 64 * j);
#pragma unroll
                        for (int j = 0; j < 4; ++j) *((f32x4*)(H + (size_t)row * 1024) + lane + 64 * j) = v[j]; }
                    norm_store(v, ng, HN + (size_t)row * 1024, lane);
                }
            } else if (kind == 8) {
                for (int row = 32768 + gw; row < RT; row += NGW) {
                    f32x4 v[4]; const float* pr = (const float*)(ws + WS_KR) + (size_t)(row - 32768) * 1024;
#pragma unroll
                    for (int j = 0; j < 4; ++j) v[j] = *((const f32x4*)(H + (size_t)row * 1024) + lane + 64 * j);
                    for (int s = 0; s < 8; ++s)
#pragma unroll
                        for (int j = 0; j < 4; ++j) v[j] += *((const f32x4*)(pr + (size_t)s * 512 * 1024) + lane + 64 * j);
                    const size_t orow = (size_t)3 * 8192 + (row - 3 * LP - 128);
#pragma unroll
                    for (int j = 0; j < 4; ++j) *((f32x4*)(P.out + orow * 1024) + lane + 64 * j) = v[j];
                }
            } else if (kind == 3) {
                const float* gcq = P.in[5] + jl * 384; const float* gckv = P.in[7] + jl * 256; const float* gqf = P.in[11] + jl * 64; const float* gkf = P.in[12] + jl * 64; const float* bfg = P.in[13] + jl * 8;
                for (int row = gw; row < RT; row += NGW) {
                    const int p = row % LP; bf16_t* zrow = Z + (size_t)row * ZW; float f[8];
                    { u32x4 w = {0, 0, 0, 0}; if (lane < 48) w = *(const u32x4*)(zrow + 8 * lane); unpack8(w, f);
                      float s = 0.f;
#pragma unroll
                      for (int i = 0; i < 8; ++i) s += f[i] * f[i];
                      const float rstd = __builtin_amdgcn_rsqf(wave_sum(s) * (1.f / 384.f) + EPSN);
                      if (lane < 48) {
#pragma unroll
                          for (int i = 0; i < 8; ++i) f[i] = f[i] * rstd * gcq[8 * lane + i];
                          *(u32x4*)(CQN + (size_t)row * 384 + 8 * lane) = pack8(f); } }
                    { u32x4 w = {0, 0, 0, 0}; if (lane < 32) w = *(const u32x4*)(zrow + 384 + 8 * lane); unpack8(w, f);
                      float s = 0.f;
#pragma unroll
                      for (int i = 0; i < 8; ++i) s += f[i] * f[i];
                      const float rstd = __builtin_amdgcn_rsqf(wave_sum(s) * (1.f / 256.f) + EPSN);
                      if (lane < 32) {
#pragma unroll
                          for (int i = 0; i < 8; ++i) f[i] = f[i] * rstd * gckv[8 * lane + i];
                          *(u32x4*)(CKVN + (size_t)row * 256 + 8 * lane) = pack8(f); } }
#pragma unroll
                    for (int t = 0; t < 2; ++t) { bf16_t* ptr = zrow + 672 + 512 * t + 8 * lane; const u32x4 w = *(const u32x4*)ptr; unpack8(w, f);
                      float s = 0.f;
#pragma unroll
                      for (int i = 0; i < 8; ++i) s += f[i] * f[i];
                      const float rstd = __builtin_amdgcn_rsqf(grp8_sum(s) * (1.f / 64.f) + EPSN) * (t == 0 ? QS_FOX : 1.f);
                      const float* gg = (t == 0 ? gqf : gkf) + 8 * (lane & 7);
#pragma unroll
                      for (int i = 0; i < 8; ++i) f[i] = f[i] * rstd * gg[i];
                      *(u32x4*)ptr = pack8(f); }
                    if (lane < 8) { const float x = __uint_as_float((unsigned)zrow[2208 + lane] << 16) + bfg[lane]; LOGF[(size_t)row * 8 + lane] = (p < PADF) ? 0.f : log_sigmoid(x); }
                }
            } else if (kind == 4) {
                for (int s = bx; s < 32; s += G) {
                    const int b = s >> 3, h = s & 7; const float* src = LOGF + (size_t)b * LP * 8 + h; float* dst = CUM + (size_t)s * LP;
                    const int r0 = tid * 17, r1 = (r0 + 17 < LP) ? r0 + 17 : LP;
                    float loc = 0.f;
                    for (int r = r0; r < r1; ++r) loc += src[(size_t)r * 8];
                    float inc = loc;
#pragma unroll
                    for (int o = 1; o < 64; o <<= 1) { const float t = __shfl_up(inc, o); if (lane >= o) inc += t; }
                    float* wt = (float*)lds;
                    __syncthreads();
                    if (lane == 63) wt[wave] = inc;
                    __syncthreads();
                    float base = 0.f;
                    for (int w = 0; w < wave; ++w) base += wt[w];
                    float run = base + inc - loc;
                    for (int r = r0; r < r1; ++r) { run += src[(size_t)r * 8]; dst[r] = run * LOG2E; }
                    __syncthreads();
                }
                const float* gq = P.in[9] + jl * 96; const float* gk = P.in[10] + jl * 96;
                const int head = lane >> 3, sub = lane & 7;
                for (int row = gw; row < RT; row += NGW) {
                    const int p = row % LP; const int pos = p >= PADF ? p - PADF : 0;
                    float cs[8], sn[8];
#pragma unroll
                    for (int i = 0; i < 8; ++i) { double rv = (double)pos * invf_rev(8 * (sub & 1) + i); rv -= __builtin_floor(rv); const float rf = (float)rv; cs[i] = __builtin_amdgcn_cosf(rf); sn[i] = __builtin_amdgcn_sinf(rf); }
#pragma unroll
                    for (int t = 0; t < 2; ++t) {
                        bf16_t* nrow = t == 0 ? QRAW + (size_t)row * 768 + head * 96 : KVRAW + (size_t)row * 1024 + head * 128;
                        const bf16_t* rsrc = t == 0 ? nrow + 64 : Z + (size_t)row * ZW + 640;
                        const float* gg = t == 0 ? gq : gk;
                        float a[8], rr[8];
                        { const u32x4 w = *(const u32x4*)(nrow + 8 * sub); unpack8(w, a); }
                        { u32x4 w = {0, 0, 0, 0}; if (sub < 4) w = *(const u32x4*)(rsrc + 8 * sub); unpack8(w, rr); }
                        float s = 0.f;
#pragma unroll
                        for (int i = 0; i < 8; ++i) s += a[i] * a[i] + rr[i] * rr[i];
                        const float rstd = __builtin_amdgcn_rsqf(grp8_sum(s) * (1.f / 96.f) + EPSN);
                        const float sc = t == 0 ? QS_MLA : 1.f;
                        float outr[8];
#pragma unroll
                        for (int i = 0; i < 8; ++i) { a[i] = a[i] * rstd * gg[8 * sub + i] * sc; rr[i] = rr[i] * rstd * gg[64 + 8 * (sub & 3) + i] * sc; }
#pragma unroll
                        for (int i = 0; i < 8; ++i) { const float other = __shfl_xor(rr[i], 2); outr[i] = (sub & 2) ? rr[i] * cs[i] + other * sn[i] : rr[i] * cs[i] - other * sn[i]; }
                        *(u32x4*)(nrow + 8 * sub) = pack8(a);
                        if (sub < 4) { bf16_t* rd = t == 0 ? nrow + 64 + 8 * sub : KR + (size_t)row * 256 + head * 32 + 8 * sub; *(u32x4*)rd = pack8(outr); }
                    }
                }
            } else if (kind == 5) {
                float fbound;
                { float a = fabsf(P.in[11][jl * 64 + lane]), c = fabsf(P.in[12][jl * 64 + lane]);
#pragma unroll
                  for (int o = 1; o < 64; o <<= 1) { a = fmaxf(a, __shfl_xor(a, o)); c = fmaxf(c, __shfl_xor(c, o)); }
                  fbound = 64.f * a * c * QS_FOX * 1.02f; }
                const int vcu = (G % 8 == 0) ? (bx % 8) * (G / 8) + bx / 8 : bx;
                for (int item = vcu; item < 1088; item += G) {
                    const int seq = item < 1024 ? item >> 4 : item - 1024; const int pr = item & 15;
                    const int fox = seq >> 5, b = (seq >> 3) & 3, h = seq & 7; const size_t rb = (size_t)b * LP;
                    for (int u = 0; u < 2; ++u) {
                        int qblk; if (item >= 1024) { if (u) break; qblk = -1; } else qblk = u ? 31 - pr : pr;
                        if (fox) att::attn_unit<true>(Z + rb * ZW + 672 + 64 * h, ZW, Z + rb * ZW + 1184 + 64 * h, ZW, nullptr, Z + rb * ZW + 1696 + 64 * h, ZW, OB + rb * 1024 + 512 + 64 * h, CUM + (size_t)(b * 8 + h) * LP, fbound, qblk, (char*)lds);
                        else att::attn_unit<false>(QRAW + rb * 768 + 96 * h, 768, KVRAW + rb * 1024 + 128 * h, 1024, KR + rb * 256 + 32 * h, KVRAW + rb * 1024 + 128 * h + 64, 1024, OB + rb * 1024 + 64 * h, nullptr, 0.f, qblk, (char*)lds);
                    }
                }
            } else if (kind == 6) {
                const float* cw = P.in[16] + (size_t)jl * 3 * 1024;
                for (int item = gw; item < (RT / 16) * 2; item += NGW) {
                    const int rblk = item >> 1, col = (item & 1) * 512 + 8 * lane; const int r0 = rblk * 16; const int p0 = r0 % LP;
                    if (p0 < PADF) { for (int t = 0; t < 16; ++t) *(u32x4*)(YB + (size_t)(r0 + t) * 1024 + col) = (u32x4){0, 0, 0, 0}; continue; }
                    float w0[8], w1[8], w2[8], g2[8], g1[8], c[8], uu[8], bb[8];
#pragma unroll
                    for (int i = 0; i < 8; ++i) { w0[i] = cw[col + i]; w1[i] = cw[1024 + col + i]; w2[i] = cw[2048 + col + i]; }
                    { const bf16_t* zr = ZC + (size_t)(r0 - 2) * ZCW + col; unpack8(*(const u32x4*)(zr + 1024), c); unpack8(*(const u32x4*)(zr + 2048), uu);
#pragma unroll
                      for (int i = 0; i < 8; ++i) g2[i] = c[i] * uu[i]; }
                    { const bf16_t* zr = ZC + (size_t)(r0 - 1) * ZCW + col; unpack8(*(const u32x4*)(zr + 1024), c); unpack8(*(const u32x4*)(zr + 2048), uu);
#pragma unroll
                      for (int i = 0; i < 8; ++i) g1[i] = c[i] * uu[i]; }
                    for (int t = 0; t < 16; ++t) { const bf16_t* zr = ZC + (size_t)(r0 + t) * ZCW + col;
                        unpack8(__builtin_nontemporal_load((const u32x4*)zr), bb); unpack8(__builtin_nontemporal_load((const u32x4*)(zr + 1024)), c); unpack8(__builtin_nontemporal_load((const u32x4*)(zr + 2048)), uu);
                        float y[8];
#pragma unroll
                        for (int i = 0; i < 8; ++i) { const float g0 = c[i] * uu[i]; y[i] = bb[i] * (w0[i] * g2[i] + w1[i] * g1[i] + w2[i] * g0); g2[i] = g1[i]; g1[i] = g0; }
                        *(u32x4*)(YB + (size_t)(r0 + t) * 1024 + col) = pack8(y); }
                }
            }
            if (sync) xcd_barrier(xbar); else __syncthreads();
        }
    }
}

extern "C" void kernel_launch(void* const* d_in, const int* in_sizes, int n_in, void* d_out, int out_size, void* d_ws, size_t ws_size, hipStream_t stream) {
    static int grid_blocks = 0;
    if (!grid_blocks) {
        int dev = 0, cus = 0, per_cu = 0;
        hipGetDevice(&dev);
        hipDeviceGetAttribute(&cus, hipDeviceAttributeMultiprocessorCount, dev);
        hipFuncSetAttribute((const void*)fwd_megakernel, hipFuncAttributeMaxDynamicSharedMemorySize, LDS_BYTES);
        hipOccupancyMaxActiveBlocksPerMultiprocessor(&per_cu, (const void*)fwd_megakernel, NTHR, LDS_BYTES);
        if (per_cu < 1) per_cu = 1;
        grid_blocks = cus * per_cu;
        if (ws_size < WS_END) fprintf(stderr, "kernel_launch: workspace too small: %zu < %zu\n", ws_size, (size_t)WS_END);
        if (n_in != 20) fprintf(stderr, "kernel_launch: expected 20 inputs, got %d\n", n_in);
    }
    Params p{};
    for (int i = 0; i < 20; ++i) p.in[i] = (const float*)d_in[i];
    p.out = (float*)d_out; p.ws = (unsigned char*)d_ws;
    void* args[] = {&p};
    hipError_t e = hipLaunchCooperativeKernel((const void*)fwd_megakernel, dim3(grid_blocks), dim3(NTHR), args, LDS_BYTES, stream);
    if (e != hipSuccess) fprintf(stderr, "cooperative launch failed: %s (grid %d)\n", hipGetErrorString(e), grid_blocks);
}
```
